# Optimizing an MI355X kernel written in HIP

```python
import jax, jax.numpy as jnp
from jax import lax
import numpy as np

D_MODEL = 1024
BATCH = 1
SEQ = 16384
DEPTH = 1
DEC_BATCH = 8
DEC_SEQ = 8192
PAST_LEN = 128

MIX_WIDTH = D_MODEL
FOURIER_WIDTH = MIX_WIDTH // 2
FOURIER_GROUP_DIM = 128
FOURIER_GROUPS = FOURIER_WIDTH // FOURIER_GROUP_DIM
SGU_WIDTH = MIX_WIDTH - FOURIER_WIDTH
SGU_HEAD_DIM = 128
SGU_HEADS = SGU_WIDTH // SGU_HEAD_DIM
CHUNK = 128
IN_COLS = FOURIER_WIDTH + 2 * SGU_WIDTH
D_FF = 2816
CONV_WIDTH = 3
EPS = 1e-6

kernel_name = "fnet_gmlp_hybrid_encoder"


def _rmsnorm(x, g):
    xf = x.astype(jnp.float32)
    y = xf * lax.rsqrt(jnp.mean(xf * xf, axis=-1, keepdims=True) + EPS)
    return (y * g.astype(jnp.float32)).astype(x.dtype)


def _token_mixer(h, w_in, sgu_norm, w_spatial, b_spatial, w_out):
    b, s, _ = h.shape
    z = h @ w_in
    zf = z[..., :FOURIER_WIDTH].reshape(b, s, FOURIER_GROUPS, FOURIER_GROUP_DIM)
    f = jnp.fft.fft2(zf.astype(jnp.float32), axes=(1, 3), norm="ortho").real
    f = f.astype(h.dtype).reshape(b, s, FOURIER_WIDTH)
    zs = jax.nn.gelu(z[..., FOURIER_WIDTH:])
    u = zs[..., :SGU_WIDTH]
    v = zs[..., SGU_WIDTH:].reshape(b, s, SGU_HEADS, SGU_HEAD_DIM)
    v = _rmsnorm(v, sgu_norm)
    v = v.reshape(b, s // CHUNK, CHUNK, SGU_HEADS, SGU_HEAD_DIM)
    sv = jnp.einsum('hpq,bnqhc->bnphc', w_spatial, v) + b_spatial.T[None, None, :, :, None]
    g = u * sv.reshape(b, s, SGU_WIDTH)
    return jnp.concatenate([f, g], axis=-1) @ w_out


def _channel_mixer(h, w_up, conv_w, conv_b, w_down):
    a = h @ w_up
    ap = jnp.pad(a, ((0, 0), (1, 1), (0, 0)))
    a = ap[:, :-2] * conv_w[0] + ap[:, 1:-1] * conv_w[1] + ap[:, 2:] * conv_w[2] + conv_b
    gate, up = a[..., :D_FF], a[..., D_FF:]
    return (jax.nn.gelu(gate) * up) @ w_down


def _trunk(x, pre_mix_norm, w_in, sgu_norm, w_spatial, b_spatial, w_out, post_mix_norm,
           pre_ffn_norm, w_up, conv_w, conv_b, w_down, post_ffn_norm):
    for l in range(DEPTH):
        m = _token_mixer(_rmsnorm(x, pre_mix_norm[l]), w_in[l], sgu_norm[l],
                         w_spatial[l], b_spatial[l], w_out[l])
        x = x + _rmsnorm(m, post_mix_norm[l])
        c = _channel_mixer(_rmsnorm(x, pre_ffn_norm[l]), w_up[l], conv_w[l], conv_b[l], w_down[l])
        x = x + _rmsnorm(c, post_ffn_norm[l])
    return x


def setup_inputs(seed: int = 0) -> dict:
    key = jax.random.key(seed)
    ks = jax.random.split(key, 16)
    f32 = jnp.float32
    nrm = lambda k, shp, sc: jax.random.normal(k, shp, f32) * sc
    gain = lambda k, shp: 1.0 + 0.05 * jax.random.normal(k, shp, f32)
    return {
        "x_prompt": jax.random.normal(ks[0], (BATCH, SEQ, D_MODEL), f32),
        "x_sample": jax.random.normal(ks[1], (DEC_BATCH, DEC_SEQ, D_MODEL), f32),
        "pre_mix_norm": gain(ks[2], (DEPTH, D_MODEL)),
        "w_in": nrm(ks[3], (DEPTH, D_MODEL, IN_COLS), D_MODEL ** -0.5),
        "sgu_norm": gain(ks[4], (DEPTH, SGU_HEADS, SGU_HEAD_DIM)),
        "w_spatial": nrm(ks[5], (DEPTH, SGU_HEADS, CHUNK, CHUNK), CHUNK ** -0.5),
        "b_spatial": nrm(ks[6], (DEPTH, SGU_HEADS, CHUNK), 0.02),
        "w_out": nrm(ks[7], (DEPTH, MIX_WIDTH, D_MODEL), MIX_WIDTH ** -0.5),
        "post_mix_norm": gain(ks[8], (DEPTH, D_MODEL)),
        "pre_ffn_norm": gain(ks[9], (DEPTH, D_MODEL)),
        "w_up": nrm(ks[10], (DEPTH, D_MODEL, 2 * D_FF), D_MODEL ** -0.5),
        "conv_w": nrm(ks[11], (DEPTH, CONV_WIDTH, 2 * D_FF), CONV_WIDTH ** -0.5),
        "conv_b": nrm(ks[12], (DEPTH, 2 * D_FF), 0.02),
        "w_down": nrm(ks[13], (DEPTH, D_FF, D_MODEL), D_FF ** -0.5),
        "post_ffn_norm": gain(ks[14], (DEPTH, D_MODEL)),
    }


def reference(x_prompt, x_sample, pre_mix_norm, w_in, sgu_norm, w_spatial, b_spatial, w_out,
              post_mix_norm, pre_ffn_norm, w_up, conv_w, conv_b, w_down, post_ffn_norm):
    y_prompt = _trunk(x_prompt, pre_mix_norm, w_in, sgu_norm, w_spatial, b_spatial, w_out,
                      post_mix_norm, pre_ffn_norm, w_up, conv_w, conv_b, w_down, post_ffn_norm)
    y_sample = _trunk(x_sample, pre_mix_norm, w_in, sgu_norm, w_spatial, b_spatial, w_out,
                      post_mix_norm, pre_ffn_norm, w_up, conv_w, conv_b, w_down, post_ffn_norm)
    return (y_prompt, y_sample)
```

```cpp
#define N_LAUNCHES 1

#include <hip/hip_runtime.h>
#include <hip/hip_cooperative_groups.h>
#include <cstdio>
namespace cg = cooperative_groups;

#define LAS __attribute__((address_space(3)))
typedef unsigned short bf16_t;
typedef short bf16x8 __attribute__((ext_vector_type(8)));
typedef short bf16x4 __attribute__((ext_vector_type(4)));
typedef float f32x4 __attribute__((ext_vector_type(4)));
typedef float f32x2 __attribute__((ext_vector_type(2)));
typedef unsigned u32x4 __attribute__((ext_vector_type(4)));
typedef unsigned u32x2 __attribute__((ext_vector_type(2)));

constexpr int MTOK = 81920, DM = 1024, DFF = 2816, N1 = 1536, N3 = 5632;
constexpr int NTHR = 512;
constexpr float EPS = 1e-6f;

constexpr size_t MiB = 1024ull * 1024ull;
constexpr size_t WS_W1T = 0;
constexpr size_t WS_W2T = WS_W1T + 4 * MiB;
constexpr size_t WS_W3T = WS_W2T + 2 * MiB;
constexpr size_t WS_W4T = WS_W3T + 11 * MiB;
constexpr size_t WS_WSP = WS_W4T + 6 * MiB;
constexpr size_t WS_WA128 = WS_WSP + 128 * 1024;
constexpr size_t WS_WA64 = WS_WA128 + 128 * 1024;
constexpr size_t WS_WB = WS_WA64 + 32 * 1024;
constexpr size_t WS_TW = WS_WB + 64 * 1024;
constexpr size_t WS_WC = WS_TW + 128 * 1024;
constexpr size_t WS_BAR = 24 * MiB - 16384;
constexpr size_t WS_SSQM = 24 * MiB;
constexpr size_t WS_SSQC = 29 * MiB;
constexpr size_t ACT = (size_t)MTOK * DM * 2;
constexpr size_t WS_CAT = 34 * MiB;
constexpr size_t WS_C = WS_CAT;
constexpr size_t WS_H2R = WS_CAT + 160 * MiB;
constexpr size_t WS_H2 = WS_H2R + 256 * DM * 2;
constexpr size_t WS_BIG = WS_H2R + 161 * MiB;
constexpr size_t WS_H0 = WS_BIG, WS_U = WS_BIG + ACT, WS_V = WS_BIG + ACT + ACT / 2, WS_HID = WS_BIG;
constexpr size_t WS_M = WS_BIG + 440 * MiB;
constexpr size_t WS_END = WS_M + 160 * MiB;

constexpr int LDS_BYTES = 144 * 1024;

typedef __bf16 bf16x2_t __attribute__((ext_vector_type(2)));
__device__ __forceinline__ unsigned cvt_pk_bf16(float lo, float hi) { const f32x2 v = {lo, hi}; const bf16x2_t b = __builtin_convertvector(v, bf16x2_t); return __builtin_bit_cast(unsigned, b); }
__device__ __forceinline__ float bf_lo(unsigned w) { return __uint_as_float(w << 16); }
__device__ __forceinline__ float bf_hi(unsigned w) { return __uint_as_float(w & 0xffff0000u); }
__device__ __forceinline__ float gelu_f(float x) {
    const float x2 = x * x;
    const float t = x * (-2.302208198f + -0.1029432397f * x2);
    return x * __builtin_amdgcn_rcpf(1.0f + __builtin_amdgcn_exp2f(t));
}
__device__ __forceinline__ float dpp_ror1(float x) { return __builtin_bit_cast(float, __builtin_amdgcn_update_dpp(0, __builtin_bit_cast(int, x), 0x121, 0xf, 0xf, false)); }
__device__ __forceinline__ float dpp_rol1(float x) { return __builtin_bit_cast(float, __builtin_amdgcn_update_dpp(0, __builtin_bit_cast(int, x), 0x12F, 0xf, 0xf, false)); }

namespace pg8 {
constexpr int BM = 256, BK = 64, HALF = 128, HTB = HALF * BK * 2, STAGE_BYTES = 8 * HTB, NXCD = 8, WGM = 8;
__device__ __forceinline__ int lds_byte(int r, int c) { const int st = (r >> 4) * 2 + (c >> 5), rr = r & 15, cc = c & 31, ob = rr * 64 + cc * 2; return st * 1024 + (ob ^ (((ob >> 9) & 1) << 5)); }
__device__ __forceinline__ void stage_rc(int b, int& R, int& C) { const int st = b / 1024, sb = b % 1024, swz = sb ^ (((sb >> 9) & 1) << 5); R = (st >> 1) * 16 + swz / 64; C = (st & 1) * 32 + (swz % 64) / 2; }
__device__ __forceinline__ int perm32(int rho) { const int n = rho >> 4, i = rho & 15; return 8 * (i >> 2) + 4 * n + (i & 3); }
struct Unit { int row0, pn; };
struct Gemm { const bf16_t* A; const bf16_t* Bt; int K; };
struct PartOrder {
    int rowbase, rows_per_tile, nMp, nN, nb, rank;
    __device__ bool next(int i, Unit& u) const {
        const int L = i * nb + rank; if (L >= nMp * nN) return false;
        const int nig = WGM * nN, gid = L / nig, fm = gid * WGM, gsz = (nMp - fm) < WGM ? (nMp - fm) : WGM, idx = L % nig;
        u.row0 = rowbase + (fm + idx % gsz) * rows_per_tile; u.pn = idx / gsz; return true;
    }
};

template <class Epi, bool HALO>
__device__ __forceinline__ void gemm_phase(LAS unsigned char* lds, const Gemm g, const PartOrder& S, const Epi& E) {
    int tid_ = threadIdx.x; asm volatile("" : "+v"(tid_));
    const int tid = tid_, wid = __builtin_amdgcn_readfirstlane(tid >> 6), lane = tid & 63, wr = wid >> 2, wc = wid & 3, fr = lane & 15, fq = lane >> 4;
    const int K = g.K, nt = K / BK;
    unsigned voffA[2], voffB[2];
#pragma unroll
    for (int i = 0; i < 2; ++i) { int R, C; stage_rc(tid * 16 + i * 8192, R, C); const int Rb = (R & ~31) + perm32(R & 31); const int Ra = HALO ? (62 * (R >> 6) + 4 * (R & 15) + ((R >> 4) & 3)) : R;
        voffA[i] = (unsigned)(Ra * K + C) * 2u; voffB[i] = (unsigned)(Rb * K + C) * 2u; }
    const size_t kstep = (size_t)(BK * 2);
    const size_t hstepB = (size_t)HALF * K * 2;
    const size_t hstepA = (size_t)(HALO ? 124 : 128) * K * 2;
    const unsigned ldsw = (unsigned)wid * 1024u;
    const int aoff = lds_byte(wr * 64 + fr, fq * 8), boff = lds_byte(wc * 32 + fr, fq * 8);
#define PG8_SA(b, h) (((b) * 2 + (h)) * HTB)
#define PG8_SB(b, h) ((4 + (b) * 2 + (h)) * HTB)
#define PG8_STAGE(bufoff, gbase, voff) do { _Pragma("unroll") for (int _i = 0; _i < 2; ++_i) \
        __builtin_amdgcn_global_load_lds((const unsigned*)((const char*)(gbase) + (voff)[_i]), (LAS unsigned*)(lds + (bufoff) + ldsw + _i * 8192), 16, 0, 0); } while (0)
#define PG8_LDA(dst, b, h) do { _Pragma("unroll") for (int m = 0; m < 4; ++m) _Pragma("unroll") for (int k = 0; k < 2; ++k) dst[m][k] = *(const LAS bf16x8*)(lds + PG8_SA(b, h) + aoff + m * 2048 + k * 1024); } while (0)
#define PG8_LDB(dst, b, h) do { _Pragma("unroll") for (int n = 0; n < 2; ++n) _Pragma("unroll") for (int k = 0; k < 2; ++k) dst[n][k] = *(const LAS bf16x8*)(lds + PG8_SB(b, h) + boff + n * 2048 + k * 1024); } while (0)
#define PG8_MMA(ai, bj, At, Bt) do { __builtin_amdgcn_s_setprio(1); _Pragma("unroll") for (int m = 0; m < 4; ++m) _Pragma("unroll") for (int n = 0; n < 2; ++n) _Pragma("unroll") for (int k = 0; k < 2; ++k) \
        acc[ai][bj][m][n] = __builtin_amdgcn_mfma_f32_16x16x32_bf16(Bt[n][k], At[m][k], acc[ai][bj][m][n], 0, 0, 0); __builtin_amdgcn_s_setprio(0); } while (0)
#define PG8_WAIT_V(n) asm volatile("s_waitcnt vmcnt(" #n ")" ::: "memory")
#define PG8_WAIT_L(n) asm volatile("s_waitcnt lgkmcnt(" #n ")" ::: "memory")
#define PG8_BAR __builtin_amdgcn_s_barrier()
#define PG8_SCHED __builtin_amdgcn_sched_barrier(0)
    Unit cur, nxt; int ui = 0;
    if (!S.next(0, cur)) return;
    f32x4 acc[2][2][4][2];
#pragma unroll
    for (int a = 0; a < 2; ++a)
#pragma unroll
        for (int b = 0; b < 2; ++b)
#pragma unroll
            for (int m = 0; m < 4; ++m)
#pragma unroll
                for (int n = 0; n < 2; ++n) acc[a][b][m][n] = (f32x4){0.f, 0.f, 0.f, 0.f};
    bf16x8 At[4][2], B0[2][2], B1[2][2];
    const char* cA = (const char*)g.A + (long)(cur.row0 - (HALO ? 1 : 0)) * (long)K * 2; const char* cB = (const char*)g.Bt + (size_t)cur.pn * 2 * hstepB;
    PG8_STAGE(PG8_SB(0, 0), cB, voffB); PG8_STAGE(PG8_SB(0, 1), cB + hstepB, voffB); PG8_STAGE(PG8_SA(0, 0), cA, voffA); PG8_STAGE(PG8_SA(0, 1), cA + hstepA, voffA);
    if (wr == 1) PG8_BAR;
    PG8_WAIT_V(2); PG8_BAR;
    PG8_STAGE(PG8_SB(1, 0), cB + kstep, voffB); PG8_STAGE(PG8_SA(1, 0), cA + kstep, voffA); PG8_STAGE(PG8_SB(1, 1), cB + hstepB + kstep, voffB);
    PG8_WAIT_V(6); PG8_BAR;
    for (;;) {
        const bool has_next = S.next(ui + 1, nxt);
        const char* nA = has_next ? (const char*)g.A + (long)(nxt.row0 - (HALO ? 1 : 0)) * (long)K * 2 : cA; const char* nB = has_next ? (const char*)g.Bt + (size_t)nxt.pn * 2 * hstepB : cB;
        for (int t = 0; t < nt; t += 2) {
            const bool last = (t == nt - 2);
            const char* a1 = cA + (size_t)(t + 1) * kstep;
            const char* a2 = last ? nA : cA + (size_t)(t + 2) * kstep; const char* b2 = last ? nB : cB + (size_t)(t + 2) * kstep;
            const char* a3 = a2 + kstep; const char* b3 = b2 + kstep;
            PG8_LDB(B0, 0, 0); PG8_LDB(B1, 0, 1); PG8_SCHED; PG8_LDA(At, 0, 0); PG8_STAGE(PG8_SA(1, 1), a1 + hstepA, voffA);
            PG8_WAIT_V(8); PG8_WAIT_L(0); PG8_BAR; PG8_MMA(0, 0, At, B0); PG8_MMA(0, 1, At, B1); PG8_BAR; PG8_SCHED;
            PG8_LDA(At, 0, 1); PG8_STAGE(PG8_SB(0, 0), b2, voffB); PG8_STAGE(PG8_SB(0, 1), b2 + hstepB, voffB); PG8_STAGE(PG8_SA(0, 0), a2, voffA);
            PG8_WAIT_V(8); PG8_WAIT_L(0); PG8_BAR; PG8_MMA(1, 0, At, B0); PG8_MMA(1, 1, At, B1); PG8_BAR; PG8_SCHED;
            PG8_LDB(B0, 1, 0); PG8_LDB(B1, 1, 1); PG8_SCHED; PG8_LDA(At, 1, 0); PG8_STAGE(PG8_SA(0, 1), a2 + hstepA, voffA);
            PG8_WAIT_V(8); PG8_WAIT_L(0); PG8_BAR; PG8_MMA(0, 0, At, B0); PG8_MMA(0, 1, At, B1); PG8_BAR; PG8_SCHED;
            PG8_LDA(At, 1, 1); PG8_STAGE(PG8_SB(1, 0), b3, voffB); PG8_STAGE(PG8_SB(1, 1), b3 + hstepB, voffB); PG8_STAGE(PG8_SA(1, 0), a3, voffA);
            PG8_WAIT_V(8); PG8_WAIT_L(0); PG8_BAR; PG8_MMA(1, 0, At, B0); PG8_MMA(1, 1, At, B1); PG8_BAR; PG8_SCHED;
        }
        if (wr == 0) PG8_BAR;
        E(acc, cur, wr, wc, fr, fq);
        if (!has_next) break;
#pragma unroll
        for (int a = 0; a < 2; ++a)
#pragma unroll
            for (int b = 0; b < 2; ++b)
#pragma unroll
                for (int m = 0; m < 4; ++m)
#pragma unroll
                    for (int n = 0; n < 2; ++n) acc[a][b][m][n] = (f32x4){0.f, 0.f, 0.f, 0.f};
        cur = nxt; cA = nA; cB = nB; ++ui;
        if (wr == 1) PG8_BAR;
    }
    PG8_WAIT_V(0);
    PG8_BAR;
#undef PG8_SA
#undef PG8_SB
#undef PG8_STAGE
#undef PG8_LDA
#undef PG8_LDB
#undef PG8_MMA
#undef PG8_WAIT_V
#undef PG8_WAIT_L
#undef PG8_BAR
#undef PG8_SCHED
}
}

struct EpiZ {
    bf16_t* Y; bf16_t* U; bf16_t* V;
    __device__ __forceinline__ void operator()(const f32x4 (&acc)[2][2][4][2], const pg8::Unit& u, int wr, int wc, int fr, int fq) const {
        const int row0 = u.row0 + wr * 64 + fr;
        bf16_t* base; int ld, colt; bool act;
        if (u.pn < 2) { base = Y; ld = 512; colt = u.pn * 256; act = false; }
        else if (u.pn < 4) { base = U; ld = 512; colt = (u.pn - 2) * 256; act = true; }
        else { base = V; ld = 512; colt = (u.pn - 4) * 256; act = true; }
        const int col0 = colt + wc * 32 + 8 * fq;
#pragma unroll
        for (int ai = 0; ai < 2; ++ai)
#pragma unroll
            for (int m = 0; m < 4; ++m) { bf16_t* rowp = base + (size_t)(row0 + ai * 128 + m * 16) * ld + col0;
#pragma unroll
                for (int bj = 0; bj < 2; ++bj) { f32x4 v0 = acc[ai][bj][m][0], v1 = acc[ai][bj][m][1];
                    if (act) {
#pragma unroll
                        for (int e = 0; e < 4; ++e) { v0[e] = gelu_f(v0[e]); v1[e] = gelu_f(v1[e]); } }
                    u32x4 w; w.x = cvt_pk_bf16(v0[0], v0[1]); w.y = cvt_pk_bf16(v0[2], v0[3]); w.z = cvt_pk_bf16(v1[0], v1[1]); w.w = cvt_pk_bf16(v1[2], v1[3]);
                    *(u32x4*)(rowp + bj * 128) = w; } }
    }
};
struct EpiMS {
    bf16_t* O; float* SSQ;
    __device__ __forceinline__ void operator()(const f32x4 (&acc)[2][2][4][2], const pg8::Unit& u, int wr, int wc, int fr, int fq) const {
        const int row0 = u.row0 + wr * 64 + fr; const int col0 = u.pn * 256 + wc * 32 + 8 * fq;
#pragma unroll
        for (int ai = 0; ai < 2; ++ai)
#pragma unroll
            for (int m = 0; m < 4; ++m) { const int row = row0 + ai * 128 + m * 16; bf16_t* rowp = O + (size_t)row * 1024 + col0; float s = 0.f;
#pragma unroll
                for (int bj = 0; bj < 2; ++bj) { const f32x4 v0 = acc[ai][bj][m][0], v1 = acc[ai][bj][m][1];
                    s += (v0[0] * v0[0] + v0[1] * v0[1]) + (v0[2] * v0[2] + v0[3] * v0[3]) + (v1[0] * v1[0] + v1[1] * v1[1]) + (v1[2] * v1[2] + v1[3] * v1[3]);
                    u32x4 w; w.x = cvt_pk_bf16(v0[0], v0[1]); w.y = cvt_pk_bf16(v0[2], v0[3]); w.z = cvt_pk_bf16(v1[0], v1[1]); w.w = cvt_pk_bf16(v1[2], v1[3]);
                    *(u32x4*)(rowp + bj * 128) = w; }
                s += __shfl_xor(s, 16); s += __shfl_xor(s, 32);
                if (fq == 0) SSQ[(size_t)row * 16 + u.pn * 4 + wc] = s; }
    }
};
__device__ __forceinline__ void panel_wait(unsigned* cnt, int wid, int lane) {
    asm volatile("s_waitcnt vmcnt(0)" ::: "memory");
    if (lane == 0) __hip_atomic_fetch_add(cnt, 1u, __ATOMIC_RELAXED, __HIP_MEMORY_SCOPE_AGENT);
    if (wid == 0) {
        unsigned spins = 0;
        while ((unsigned)__builtin_amdgcn_readfirstlane(__hip_atomic_load(cnt, __ATOMIC_RELAXED, __HIP_MEMORY_SCOPE_AGENT)) < 32u) { if (++spins > (1u << 22)) break; __builtin_amdgcn_s_sleep(1); }
        __builtin_amdgcn_fence(__ATOMIC_ACQUIRE, "agent");
        asm volatile("s_waitcnt vmcnt(0)" ::: "memory");
    }
    asm volatile("" ::: "memory"); __builtin_amdgcn_s_barrier(); asm volatile("" ::: "memory");
}
__device__ __forceinline__ float sum16(const float* p) {
    const f32x4 s0 = *(const f32x4*)p, s1 = *(const f32x4*)(p + 4), s2 = *(const f32x4*)(p + 8), s3 = *(const f32x4*)(p + 12);
    return ((s0[0] + s0[1]) + (s0[2] + s0[3])) + ((s1[0] + s1[1]) + (s1[2] + s1[3])) + ((s2[0] + s2[1]) + (s2[2] + s2[3])) + ((s3[0] + s3[1]) + (s3[2] + s3[3]));
}
struct EpiY {
    float* out; const bf16_t* H2; const float* IRS; float* SSQ; unsigned* cnt; const float* g3;
    __device__ __forceinline__ void operator()(f32x4 (&acc)[2][2][4][2], const pg8::Unit& u, int wr, int wc, int fr, int fq) const {
        const int row0 = u.row0 + wr * 64 + fr; const int col0 = u.pn * 256 + wc * 32 + 8 * fq;
        const int wid = wr * 4 + wc, lane = fq * 16 + fr;
#pragma unroll
        for (int ai = 0; ai < 2; ++ai)
#pragma unroll
            for (int m = 0; m < 4; ++m) { const int row = row0 + ai * 128 + m * 16; float s = 0.f;
#pragma unroll
                for (int bj = 0; bj < 2; ++bj) { const f32x4 v0 = acc[ai][bj][m][0], v1 = acc[ai][bj][m][1];
                    s += (v0[0] * v0[0] + v0[1] * v0[1]) + (v0[2] * v0[2] + v0[3] * v0[3]) + (v1[0] * v1[0] + v1[1] * v1[1]) + (v1[2] * v1[2] + v1[3] * v1[3]); }
                s += __shfl_xor(s, 16); s += __shfl_xor(s, 32);
                if (fq == 0) __hip_atomic_store(SSQ + (size_t)row * 16 + u.pn * 4 + wc, s, __ATOMIC_RELAXED, __HIP_MEMORY_SCOPE_AGENT); }
        panel_wait(cnt + (u.row0 >> 8), wid, lane);
        f32x4 gv[2][2];
#pragma unroll
        for (int bj = 0; bj < 2; ++bj) { gv[bj][0] = *(const f32x4*)(g3 + col0 + bj * 128); gv[bj][1] = *(const f32x4*)(g3 + col0 + bj * 128 + 4); }
        float rscv[8], irsv[8];
#pragma unroll
        for (int k = 0; k < 8; ++k) { const int row = row0 + (k >> 2) * 128 + (k & 3) * 16; rscv[k] = sum16(SSQ + (size_t)row * 16); irsv[k] = IRS[(size_t)row * 16]; }
#pragma unroll
        for (int k = 0; k < 8; ++k) rscv[k] = rsqrtf(rscv[k] * (1.0f / 1024.0f) + EPS);
#pragma unroll
        for (int ai = 0; ai < 2; ++ai)
#pragma unroll
            for (int m = 0; m < 4; ++m) { const int row = row0 + ai * 128 + m * 16;
                const float rsc = rscv[ai * 4 + m]; const float irs = irsv[ai * 4 + m];
#pragma unroll
                for (int bj = 0; bj < 2; ++bj) { const u32x4 hw = *(const u32x4*)(H2 + (size_t)row * DM + col0 + bj * 128);
                    const f32x4 c0 = acc[ai][bj][m][0], c1 = acc[ai][bj][m][1]; f32x4 y0, y1;
                    y0[0] = bf_lo(hw.x) * irs + c0[0] * rsc * gv[bj][0][0]; y0[1] = bf_hi(hw.x) * irs + c0[1] * rsc * gv[bj][0][1];
                    y0[2] = bf_lo(hw.y) * irs + c0[2] * rsc * gv[bj][0][2]; y0[3] = bf_hi(hw.y) * irs + c0[3] * rsc * gv[bj][0][3];
                    y1[0] = bf_lo(hw.z) * irs + c1[0] * rsc * gv[bj][1][0]; y1[1] = bf_hi(hw.z) * irs + c1[1] * rsc * gv[bj][1][1];
                    y1[2] = bf_lo(hw.w) * irs + c1[2] * rsc * gv[bj][1][2]; y1[3] = bf_hi(hw.w) * irs + c1[3] * rsc * gv[bj][1][3];
                    float* op = out + (size_t)row * DM + col0 + bj * 128; *(f32x4*)op = y0; *(f32x4*)(op + 4) = y1; }
                if (m & 1) asm volatile("" ::: "memory"); }
    }
};
__device__ __forceinline__ float dpp_shr1(float x) { return __builtin_bit_cast(float, __builtin_amdgcn_update_dpp(0, __builtin_bit_cast(int, x), 0x111, 0xf, 0xf, true)); }
__device__ __forceinline__ float dpp_shl1(float x) { return __builtin_bit_cast(float, __builtin_amdgcn_update_dpp(0, __builtin_bit_cast(int, x), 0x101, 0xf, 0xf, true)); }
__device__ __forceinline__ f32x2 gelu2(f32x2 x) {
    const f32x2 x2 = x * x;
    const f32x2 t = x * (x2 * -0.1029432397f + -2.302208198f);
    f32x2 d; d.x = __builtin_amdgcn_exp2f(t.x); d.y = __builtin_amdgcn_exp2f(t.y);
    d = d + 1.0f;
    f32x2 rc; rc.x = __builtin_amdgcn_rcpf(d.x); rc.y = __builtin_amdgcn_rcpf(d.y);
    return x * rc;
}
__device__ __forceinline__ void ffn_conv(f32x4 (&acc)[2][2][4][2], const float* cw, const float* cb, int cg0, unsigned firstm, unsigned lastm, const bool MASK) {
    f32x2 Wc[8], Wn[8];
#define FFN_LOADW(W, idx) do { const int cge_ = cg0 + 4 * ((idx) >> 1) + 2 * ((idx) & 1); \
        W[0] = *(const f32x2*)(cw + cge_); W[1] = *(const f32x2*)(cw + N3 + cge_); W[2] = *(const f32x2*)(cw + 2 * N3 + cge_); W[3] = *(const f32x2*)(cb + cge_); \
        W[4] = *(const f32x2*)(cw + DFF + cge_); W[5] = *(const f32x2*)(cw + N3 + DFF + cge_); W[6] = *(const f32x2*)(cw + 2 * N3 + DFF + cge_); W[7] = *(const f32x2*)(cb + DFF + cge_); } while (0)
    FFN_LOADW(Wc, 0);
#pragma unroll
    for (int idx = 0; idx < 4; ++idx) {
        const int n = idx >> 1, ep = idx & 1;
        if (idx < 3) FFN_LOADW(Wn, idx + 1);
        const f32x2 W0g = Wc[0], W1g = Wc[1], W2g = Wc[2], Bg = Wc[3], W0u = Wc[4], W1u = Wc[5], W2u = Wc[6], Bu = Wc[7];
#pragma unroll
        for (int ai = 0; ai < 2; ++ai) {
            f32x2 g[4], u[4], r[4];
#pragma unroll
            for (int m = 0; m < 4; ++m) { g[m] = ep ? acc[ai][0][m][n].hi : acc[ai][0][m][n].lo; u[m] = ep ? acc[ai][1][m][n].hi : acc[ai][1][m][n].lo; }
            f32x2 gup0, gdn3, uup0, udn3;
            gup0.x = dpp_shr1(g[3].x); gup0.y = dpp_shr1(g[3].y); gdn3.x = dpp_shl1(g[0].x); gdn3.y = dpp_shl1(g[0].y);
            uup0.x = dpp_shr1(u[3].x); uup0.y = dpp_shr1(u[3].y); udn3.x = dpp_shl1(u[0].x); udn3.y = dpp_shl1(u[0].y);
#pragma unroll
            for (int m = 0; m < 4; ++m) { const int bit = ai * 4 + m;
                f32x2 gu = m ? g[m > 0 ? m - 1 : 0] : gup0, gd = m < 3 ? g[m < 3 ? m + 1 : 3] : gdn3;
                f32x2 uu = m ? u[m > 0 ? m - 1 : 0] : uup0, ud = m < 3 ? u[m < 3 ? m + 1 : 3] : udn3;
                if (MASK) { if ((firstm >> bit) & 1u) { gu = (f32x2){0.f, 0.f}; uu = (f32x2){0.f, 0.f}; }
                            if ((lastm >> bit) & 1u) { gd = (f32x2){0.f, 0.f}; ud = (f32x2){0.f, 0.f}; } }
                const f32x2 gv = Bg + W0g * gu + W1g * g[m] + W2g * gd;
                const f32x2 uv = Bu + W0u * uu + W1u * u[m] + W2u * ud;
                r[m] = gelu2(gv) * uv; }
            asm volatile("" : "+v"(r[0]), "+v"(r[1]), "+v"(r[2]), "+v"(r[3]));
#pragma unroll
            for (int m = 0; m < 4; ++m) { if (ep) acc[ai][0][m][n].hi = r[m]; else acc[ai][0][m][n].lo = r[m]; }
        }
#pragma unroll
        for (int k = 0; k < 8; ++k) Wc[k] = Wn[k];
    }
#undef FFN_LOADW
}
struct EpiFFN {
    bf16_t* HID; const float* cw; const float* cb; int rowend;
    __device__ __forceinline__ void operator()(f32x4 (&acc)[2][2][4][2], const pg8::Unit& u, int wr, int wc, int fr, int fq) const {
        const int cg0 = u.pn * 128 + wc * 32 + 8 * fq;
        unsigned firstm = 0, lastm = 0, validm = 0;
#pragma unroll
        for (int ai = 0; ai < 2; ++ai)
#pragma unroll
            for (int m = 0; m < 4; ++m) { const int i = 4 * fr + m; const int ga = u.row0 + 62 * (2 * ai + wr) - 1 + i; const int bit = ai * 4 + m;
                const bool first = (ga == 0) || (ga >= 16384 && (ga & 8191) == 0);
                const bool last = ((ga + 1) >= 16384 && ((ga + 1) & 8191) == 0);
                const bool valid = (i >= 1) && (i <= 62) && (ga < rowend);
                firstm |= (first ? 1u : 0u) << bit; lastm |= (last ? 1u : 0u) << bit; validm |= (valid ? 1u : 0u) << bit; }
        const bool hasb = __builtin_amdgcn_ballot_w64((firstm | lastm) != 0u) != 0ull;
        ffn_conv(acc, cw, cb, cg0, firstm, lastm, hasb);
#pragma unroll
        for (int ai = 0; ai < 2; ++ai)
#pragma unroll
            for (int m = 0; m < 4; ++m) { const int bit = ai * 4 + m; const int ga = u.row0 + 62 * (2 * ai + wr) - 1 + 4 * fr + m;
                if ((validm >> bit) & 1u) { const f32x4 v0 = acc[ai][0][m][0], v1 = acc[ai][0][m][1];
                    u32x4 w; w.x = cvt_pk_bf16(v0[0], v0[1]); w.y = cvt_pk_bf16(v0[2], v0[3]); w.z = cvt_pk_bf16(v1[0], v1[1]); w.w = cvt_pk_bf16(v1[2], v1[3]);
                    *(u32x4*)(HID + (size_t)ga * DFF + cg0) = w; } }
    }
};

template <int MT, int KS>
__device__ __forceinline__ void mix_load_w(bf16x8 (&wf)[KS][MT], const bf16_t* W, int ldw, const int (&mrow)[MT], int lane) {
    const int fr = lane & 15, g = lane >> 4;
#pragma unroll
    for (int ks = 0; ks < KS; ++ks)
#pragma unroll
        for (int i = 0; i < MT; ++i) wf[ks][i] = *(const bf16x8*)(W + (size_t)(mrow[i] + fr) * ldw + ks * 32 + 8 * g);
}
template <int MT, int KS>
__device__ __forceinline__ void mix_mma(f32x4 (&acc)[MT][8], const bf16x8 (&wf)[KS][MT], LAS const unsigned char* xt, int pitch, int ncol0, int lane) {
    const int fr = lane & 15, g = lane >> 4, q = fr >> 2, p = fr & 3;
    const int base = (8 * g + q) * pitch + (ncol0 + 4 * p) * 2;
#pragma unroll
    for (int ks = 0; ks < KS; ++ks) {
        bf16x8 xf[8];
#pragma unroll
        for (int nt = 0; nt < 8; ++nt) {
            const int a0 = base + ks * 32 * pitch + nt * 32;
            const bf16x4 lo = __builtin_amdgcn_ds_read_tr16_b64_v4i16((LAS bf16x4*)(xt + a0));
            const bf16x4 hi = __builtin_amdgcn_ds_read_tr16_b64_v4i16((LAS bf16x4*)(xt + a0 + 4 * pitch));
            xf[nt] = __builtin_shufflevector(lo, hi, 0, 1, 2, 3, 4, 5, 6, 7);
        }
#pragma unroll
        for (int nt = 0; nt < 8; ++nt)
#pragma unroll
            for (int i = 0; i < MT; ++i) acc[i][nt] = __builtin_amdgcn_mfma_f32_16x16x32_bf16(xf[nt], wf[ks][i], acc[i][nt], 0, 0, 0);
    }
}

struct Params {
    const float* x_prompt; const float* x_sample; const float* pre_mix_norm; const float* w_in; const float* sgu_norm; const float* w_spatial; const float* b_spatial;
    const float* w_out; const float* post_mix_norm; const float* pre_ffn_norm; const float* w_up; const float* conv_w; const float* conv_b; const float* w_down; const float* post_ffn_norm;
    float* out; unsigned char* ws; int never; int census; int ph_lo; int ph_hi; int ck; int pad_;
};

struct Part { int r0, r1, nb, rank, px, nx; };
__device__ __forceinline__ const float* xrow(const Params& p, int r) { return r < 16384 ? p.x_prompt + (size_t)r * DM : p.x_sample + (size_t)(r - 16384) * DM; }

__device__ void p0_prep(const Params& P, LAS unsigned char* lds, int G, const Part pt) {
    const int tid = threadIdx.x, lane = tid & 63, wave = tid >> 6;
    unsigned char* ws = P.ws;
    LAS float* ctab = (LAS float*)lds;
    if (tid < 128) ctab[tid] = cospif((float)tid * (1.0f / 64.0f));
    __syncthreads();
    const long gt = (long)blockIdx.x * NTHR + tid, GT = (long)G * NTHR;
    {
        bf16_t* W1T = (bf16_t*)(ws + WS_W1T);
        for (long it = gt; it < 128L * 1536; it += GT) {
            const int n = (int)(it % 1536), k0 = (int)(it / 1536) * 8;
            float a[8];
#pragma unroll
            for (int i = 0; i < 8; ++i) a[i] = P.w_in[(size_t)(k0 + i) * 1536 + n] * P.pre_mix_norm[k0 + i];
            u32x4 w; w.x = cvt_pk_bf16(a[0], a[1]); w.y = cvt_pk_bf16(a[2], a[3]); w.z = cvt_pk_bf16(a[4], a[5]); w.w = cvt_pk_bf16(a[6], a[7]);
            *(u32x4*)(W1T + (size_t)n * 1024 + k0) = w;
        }
        { bf16_t* WC = (bf16_t*)(ws + WS_WC);
          for (long it = gt; it < 32768; it += GT) { const int lp = (int)(it >> 7), c = (int)(it & 127), l = lp & 127, im = lp >> 7;
              WC[it] = (bf16_t)(cvt_pk_bf16(ctab[(l * c + 32 * im) & 127] * 0.08838834764831845f, 0.f) & 0xffffu); } }
    }
    {
        bf16_t* W2T = (bf16_t*)(ws + WS_W2T);
        for (long it = gt; it < 128L * 1024; it += GT) {
            const int n = (int)(it & 1023), k0 = (int)(it >> 10) * 8;
            float a[8];
#pragma unroll
            for (int i = 0; i < 8; ++i) a[i] = P.w_out[(size_t)(k0 + i) * 1024 + n];
            u32x4 w; w.x = cvt_pk_bf16(a[0], a[1]); w.y = cvt_pk_bf16(a[2], a[3]); w.z = cvt_pk_bf16(a[4], a[5]); w.w = cvt_pk_bf16(a[6], a[7]);
            *(u32x4*)(W2T + (size_t)n * 1024 + k0) = w;
        }
    }
    {
        bf16_t* W3T = (bf16_t*)(ws + WS_W3T);
        for (long it = gt; it < 128L * N3; it += GT) {
            const int np = (int)(it % N3), k0 = (int)(it / N3) * 8;
            const int pn = np >> 8, half = (np >> 7) & 1, j = np & 127, col = half * DFF + 128 * pn + j;
            float a[8];
#pragma unroll
            for (int i = 0; i < 8; ++i) a[i] = P.w_up[(size_t)(k0 + i) * N3 + col] * P.pre_ffn_norm[k0 + i];
            u32x4 w; w.x = cvt_pk_bf16(a[0], a[1]); w.y = cvt_pk_bf16(a[2], a[3]); w.z = cvt_pk_bf16(a[4], a[5]); w.w = cvt_pk_bf16(a[6], a[7]);
            *(u32x4*)(W3T + (size_t)np * 1024 + k0) = w;
        }
    }
    {
        bf16_t* W4T = (bf16_t*)(ws + WS_W4T);
        for (long it = gt; it < 352L * 1024; it += GT) {
            const int n = (int)(it & 1023), k0 = (int)(it >> 10) * 8;
            float a[8];
#pragma unroll
            for (int i = 0; i < 8; ++i) a[i] = P.w_down[(size_t)(k0 + i) * 1024 + n];
            u32x4 w; w.x = cvt_pk_bf16(a[0], a[1]); w.y = cvt_pk_bf16(a[2], a[3]); w.z = cvt_pk_bf16(a[4], a[5]); w.w = cvt_pk_bf16(a[6], a[7]);
            *(u32x4*)(W4T + (size_t)n * DFF + k0) = w;
        }
    }
    {
        bf16_t* WSP = (bf16_t*)(ws + WS_WSP); bf16_t* WA128 = (bf16_t*)(ws + WS_WA128); bf16_t* WA64 = (bf16_t*)(ws + WS_WA64); bf16_t* WB = (bf16_t*)(ws + WS_WB);
        f32x2* TW = (f32x2*)(ws + WS_TW);
        for (long it = gt; it < 65536; it += GT) {
            { const float v = P.w_spatial[it]; WSP[it] = (bf16_t)(cvt_pk_bf16(v, 0.f) & 0xffffu); }
            { const int m = (int)(it >> 8), k = (int)(it & 255); const int ka = m & 127, im = m >> 7, a = k & 127, kin = k >> 7;
              float s, c; sincospif((float)((ka * a) & 127) * (1.0f / 64.0f), &s, &c);
              const float v = (im == 0) ? (kin == 0 ? c : s) : (kin == 0 ? -s : c);
              WA128[it] = (bf16_t)(cvt_pk_bf16(v * 0.08838834764831845f, 0.f) & 0xffffu); }
            if (it < 16384) { const int m = (int)(it >> 7), k = (int)(it & 127); const int ka = m & 63, im = m >> 6, a = k & 63, kin = k >> 6;
              float s, c; sincospif((float)((ka * a) & 63) * (1.0f / 32.0f), &s, &c);
              const float v = (im == 0) ? (kin == 0 ? c : s) : (kin == 0 ? -s : c);
              WA64[it] = (bf16_t)(cvt_pk_bf16(v * 0.125f, 0.f) & 0xffffu); }
            if (it < 32768) { const int kb = (int)(it >> 8), k = (int)(it & 255); const int b = k & 127, kin = k >> 7;
              float s, c; sincospif((float)((kb * b) & 127) * (1.0f / 64.0f), &s, &c);
              const float v = (kin == 0) ? c : s;
              WB[it] = (bf16_t)(cvt_pk_bf16(v * 0.08838834764831845f, 0.f) & 0xffffu); }
            if (it < 16384) { float s, c; sincospif((float)it * (1.0f / 8192.0f), &s, &c); TW[it] = (f32x2){c, s}; }
        }
    }
    {
        bf16_t* H0 = (bf16_t*)(ws + WS_H0);
        for (int r = pt.r0 + pt.rank * 8 + wave; r < pt.r1; r += pt.nb * 8) {
            const float* xp = xrow(P, r);
            f32x4 v[4]; float s = 0.f;
#pragma unroll
            for (int i = 0; i < 4; ++i) { v[i] = *(const f32x4*)(xp + i * 256 + lane * 4); s += (v[i][0] * v[i][0] + v[i][1] * v[i][1]) + (v[i][2] * v[i][2] + v[i][3] * v[i][3]); }
#pragma unroll
            for (int o = 1; o < 64; o <<= 1) s += __shfl_xor(s, o);
            const float rs = rsqrtf(s * (1.0f / 1024.0f) + EPS);
            if (lane == 0) ((float*)(ws + WS_SSQC))[(size_t)r * 16] = 1.0f / rs;
#pragma unroll
            for (int i = 0; i < 4; ++i) { u32x2 w; w.x = cvt_pk_bf16(v[i][0] * rs, v[i][1] * rs); w.y = cvt_pk_bf16(v[i][2] * rs, v[i][3] * rs);
                *(u32x2*)(H0 + (size_t)r * DM + i * 256 + lane * 4) = w; }
        }
    }
    __syncthreads();
}

template <bool SAMPLE>
__device__ __forceinline__ void chan_stage(const bf16x8 (&wcr)[2][4], LAS const unsigned char* zt, LAS unsigned char* xt, int w, int fr, int g4) {
#pragma unroll
    for (int q = 0; q < 4; ++q) {
        bf16x8 zf[2][4];
#pragma unroll
        for (int h = 0; h < 2; ++h)
#pragma unroll
            for (int ks = 0; ks < 4; ++ks) zf[h][ks] = *(const LAS bf16x8*)(zt + (16 * (2 * q + h) + fr) * 272 + 64 * ks + 16 * g4);
        f32x4 c[2][2];
#pragma unroll
        for (int h = 0; h < 2; ++h)
#pragma unroll
            for (int t = 0; t < 2; ++t) { c[h][t] = (f32x4){0.f, 0.f, 0.f, 0.f};
#pragma unroll
                for (int ks = 0; ks < 4; ++ks) c[h][t] = __builtin_amdgcn_mfma_f32_16x16x32_bf16(wcr[t][ks], zf[h][ks], c[h][t], 0, 0, 0); }
#pragma unroll
        for (int h = 0; h < 2; ++h)
#pragma unroll
            for (int t = 0; t < 2; ++t) { const int za = 16 * (2 * q + h) + fr, lp = 32 * w + 16 * t + 4 * g4, kin = lp >> 7, l = lp & 127;
                u32x2 o; o.x = cvt_pk_bf16(c[h][t][0], c[h][t][1]); o.y = cvt_pk_bf16(c[h][t][2], c[h][t][3]);
                if (SAMPLE) { const int a = za & 63, bi = za >> 6; *(LAS u32x2*)(xt + (kin * 64 + a) * 544 + (bi * 128 + l) * 2) = o; }
                else *(LAS u32x2*)(xt + (kin * 128 + za) * 288 + l * 2) = o; }
    }
}
__device__ void p2_mix(const Params& P, LAS unsigned char* lds, int G, const Part pt) {
    const int tid = threadIdx.x, lane = tid & 63, w = __builtin_amdgcn_readfirstlane(tid >> 6), fr = lane & 15, g4 = lane >> 4;
    unsigned char* ws = P.ws;
    const bf16_t* YB = (const bf16_t*)P.out; const bf16_t* UB = (const bf16_t*)(ws + WS_U); const bf16_t* VB = (const bf16_t*)(ws + WS_V);
    bf16_t* TB = (bf16_t*)P.out + (size_t)MTOK * DM; bf16_t* CAT = (bf16_t*)(ws + WS_CAT);
    const bf16_t* WA128 = (const bf16_t*)(ws + WS_WA128); const bf16_t* WA64 = (const bf16_t*)(ws + WS_WA64); const bf16_t* WSP = (const bf16_t*)(ws + WS_WSP);
    const f32x2* TW = (const f32x2*)(ws + WS_TW);
    LAS unsigned char* zt = lds + 73728;
    bf16x8 wcr[2][4];
    { const bf16_t* WCg = (const bf16_t*)(ws + WS_WC);
#pragma unroll
      for (int t = 0; t < 2; ++t)
#pragma unroll
          for (int ks = 0; ks < 4; ++ks) wcr[t][ks] = *(const bf16x8*)(WCg + (size_t)(32 * w + 16 * t + fr) * 128 + 32 * ks + 8 * g4); }
    u32x4 zr[4];
#define Z_LOAD(uu) do { int grp_, rb_, sa_; if ((uu) < 512) { grp_ = (uu) & 3; rb_ = (uu) >> 2; sa_ = 0; } else { const int s_ = (uu) - 512, r_ = s_ & 255; grp_ = r_ & 3; rb_ = 16384 + 8192 * (s_ >> 8) + (r_ >> 2) * 2; sa_ = 1; } \
        _Pragma("unroll") for (int i = 0; i < 4; ++i) { const int idx = tid + NTHR * i, ch = idx & 15, za = idx >> 4; const int row_ = sa_ ? rb_ + 128 * (za & 63) + (za >> 6) : 128 * za + rb_; \
            zr[i] = *(const u32x4*)(YB + (size_t)row_ * 512 + 128 * grp_ + ch * 8); } } while (0)
#define Z_STORE() do { _Pragma("unroll") for (int i = 0; i < 4; ++i) { const int idx = tid + NTHR * i, ch = idx & 15, za = idx >> 4; *(LAS u32x4*)(zt + za * 272 + ch * 16) = zr[i]; } } while (0)
    if ((int)blockIdx.x < 2560) { Z_LOAD((int)blockIdx.x); Z_STORE(); }
    for (int u = blockIdx.x; u < 2560; u += G) {
        const bool more = (u + G < 2560);
        __syncthreads();
        if (u < 512) {
            const int grp = u & 3, b = u >> 2;
            const int mrow[2] = {16 * w, 128 + 16 * w};
            bf16x8 wf[8][2]; mix_load_w<2, 8>(wf, WA128, 256, mrow, lane);
            chan_stage<false>(wcr, zt, lds, w, fr, g4);
            __syncthreads();
            if (more) Z_LOAD(u + G);
            f32x4 acc[2][8];
#pragma unroll
            for (int i = 0; i < 2; ++i)
#pragma unroll
                for (int n = 0; n < 8; ++n) acc[i][n] = (f32x4){0.f, 0.f, 0.f, 0.f};
            mix_mma<2, 8>(acc, wf, lds, 288, 0, lane);
            const int ka = 16 * w + fr; const f32x2 tw = TW[ka * b]; const float cs = tw.x, sn = tw.y;
            bf16_t* op = TB + (size_t)(128 * ka + b) * DM + 256 * grp + 4 * g4;
#pragma unroll
            for (int n = 0; n < 8; ++n) { const f32x4 tr = acc[0][n], ti = acc[1][n]; u32x2 wr_, wi_;
                wr_.x = cvt_pk_bf16(cs * tr[0] + sn * ti[0], cs * tr[1] + sn * ti[1]); wr_.y = cvt_pk_bf16(cs * tr[2] + sn * ti[2], cs * tr[3] + sn * ti[3]);
                wi_.x = cvt_pk_bf16(cs * ti[0] - sn * tr[0], cs * ti[1] - sn * tr[1]); wi_.y = cvt_pk_bf16(cs * ti[2] - sn * tr[2], cs * ti[3] - sn * tr[3]);
                *(u32x2*)(op + 16 * n) = wr_; *(u32x2*)(op + 128 + 16 * n) = wi_; }
        } else {
            const int s = u - 512, samp = s >> 8, r = s & 255, grp = r & 3, b0 = (r >> 2) * 2; const int seq0 = 16384 + 8192 * samp;
            const int kblk = w & 3, bi_w = w >> 2;
            const int mrow[2] = {16 * kblk, 64 + 16 * kblk};
            bf16x8 wf[4][2]; mix_load_w<2, 4>(wf, WA64, 128, mrow, lane);
            chan_stage<true>(wcr, zt, lds, w, fr, g4);
            __syncthreads();
            if (more) Z_LOAD(u + G);
            f32x4 acc[2][8];
#pragma unroll
            for (int i = 0; i < 2; ++i)
#pragma unroll
                for (int n = 0; n < 8; ++n) acc[i][n] = (f32x4){0.f, 0.f, 0.f, 0.f};
            mix_mma<2, 4>(acc, wf, lds, 544, 128 * bi_w, lane);
            const int ka = 16 * kblk + fr, b = b0 + bi_w; const f32x2 tw = TW[2 * (ka * b)]; const float cs = tw.x, sn = tw.y;
            bf16_t* op = TB + (size_t)(seq0 + 128 * ka + b) * DM + 256 * grp + 4 * g4;
#pragma unroll
            for (int n = 0; n < 8; ++n) { const f32x4 tr = acc[0][n], ti = acc[1][n]; u32x2 wr_, wi_;
                wr_.x = cvt_pk_bf16(cs * tr[0] + sn * ti[0], cs * tr[1] + sn * ti[1]); wr_.y = cvt_pk_bf16(cs * tr[2] + sn * ti[2], cs * tr[3] + sn * ti[3]);
                wi_.x = cvt_pk_bf16(cs * ti[0] - sn * tr[0], cs * ti[1] - sn * tr[1]); wi_.y = cvt_pk_bf16(cs * ti[2] - sn * tr[2], cs * ti[3] - sn * tr[3]);
                *(u32x2*)(op + 16 * n) = wr_; *(u32x2*)(op + 128 + 16 * n) = wi_; }
        }
        if (more) Z_STORE();
    }
    __syncthreads();
#undef Z_LOAD
#undef Z_STORE
    {
        const int c0 = pt.r0 >> 7, nun = ((pt.r1 - pt.r0) >> 7) * 4;
        u32x4 xr[4];
#define SGU_LOAD(ss) do { const int chunk_ = c0 + ((ss) >> 2), h_ = (ss) & 3; _Pragma("unroll") for (int i = 0; i < 4; ++i) { const int idx = tid + NTHR * i, ch = idx & 15, q = idx >> 4; \
            xr[i] = *(const u32x4*)(VB + (size_t)(chunk_ * 128 + q) * 512 + 128 * h_ + ch * 8); } } while (0)
        if (pt.rank < nun) SGU_LOAD(pt.rank);
        for (int s = pt.rank; s < nun; s += pt.nb) {
            const int chunk = c0 + (s >> 2), h = s & 3;
            const int mrow[1] = {16 * w};
            bf16x8 wf[4][1]; mix_load_w<1, 4>(wf, WSP + h * 16384, 128, mrow, lane);
            { const int ch = tid & 15; const f32x4 g0 = *(const f32x4*)(P.sgu_norm + h * 128 + ch * 8), g1 = *(const f32x4*)(P.sgu_norm + h * 128 + ch * 8 + 4);
#pragma unroll
              for (int i = 0; i < 4; ++i) { const int idx = tid + NTHR * i, q = idx >> 4;
                float v[8]; v[0] = bf_lo(xr[i].x); v[1] = bf_hi(xr[i].x); v[2] = bf_lo(xr[i].y); v[3] = bf_hi(xr[i].y); v[4] = bf_lo(xr[i].z); v[5] = bf_hi(xr[i].z); v[6] = bf_lo(xr[i].w); v[7] = bf_hi(xr[i].w);
                float ss = 0.f;
#pragma unroll
                for (int j = 0; j < 8; ++j) ss += v[j] * v[j];
                ss += __shfl_xor(ss, 1); ss += __shfl_xor(ss, 2); ss += __shfl_xor(ss, 4); ss += __shfl_xor(ss, 8);
                const float rs = rsqrtf(ss * (1.0f / 128.0f) + EPS);
                u32x4 o; o.x = cvt_pk_bf16(v[0] * rs * g0[0], v[1] * rs * g0[1]); o.y = cvt_pk_bf16(v[2] * rs * g0[2], v[3] * rs * g0[3]);
                o.z = cvt_pk_bf16(v[4] * rs * g1[0], v[5] * rs * g1[1]); o.w = cvt_pk_bf16(v[6] * rs * g1[2], v[7] * rs * g1[3]);
                *(LAS u32x4*)(lds + q * 288 + ch * 16) = o; } }
            __syncthreads();
            if (s + pt.nb < nun) SGU_LOAD(s + pt.nb);
            f32x4 acc[1][8];
#pragma unroll
            for (int n = 0; n < 8; ++n) acc[0][n] = (f32x4){0.f, 0.f, 0.f, 0.f};
            mix_mma<1, 4>(acc, wf, lds, 288, 0, lane);
            const int p = 16 * w + fr; const float bias = P.b_spatial[h * 128 + p]; const size_t row = (size_t)chunk * 128 + p;
            const bf16_t* up = UB + row * 512 + 128 * h + 4 * g4; bf16_t* op = CAT + row * DM + 512 + 128 * h + 4 * g4;
#pragma unroll
            for (int n = 0; n < 8; ++n) { const u32x2 uu = *(const u32x2*)(up + 16 * n); const f32x4 sv = acc[0][n]; u32x2 o;
                o.x = cvt_pk_bf16(bf_lo(uu.x) * (sv[0] + bias), bf_hi(uu.x) * (sv[1] + bias)); o.y = cvt_pk_bf16(bf_lo(uu.y) * (sv[2] + bias), bf_hi(uu.y) * (sv[3] + bias));
                *(u32x2*)(op + 16 * n) = o; }
            __syncthreads();
        }
#undef SGU_LOAD
    }
}

__device__ void p3_dft2(const Params& P, LAS unsigned char* lds, int G) {
    const int tid = threadIdx.x, lane = tid & 63, w = __builtin_amdgcn_readfirstlane(tid >> 6), fr = lane & 15, g4 = lane >> 4;
    unsigned char* ws = P.ws;
    const bf16_t* TB = (const bf16_t*)P.out + (size_t)MTOK * DM; bf16_t* CAT = (bf16_t*)(ws + WS_CAT); const bf16_t* WB = (const bf16_t*)(ws + WS_WB);
    const int mrow[1] = {16 * w};
    bf16x8 wf[8][1]; mix_load_w<1, 8>(wf, WB, 256, mrow, lane);
    u32x4 xr[8];
#define P3_LOAD(uu) do { const int chunk_ = (uu) >> 2, grp_ = (uu) & 3; _Pragma("unroll") for (int i = 0; i < 8; ++i) { const int idx = tid + NTHR * i, ch = idx & 15, kp = idx >> 4, kin = kp >> 7, b = kp & 127; \
        xr[i] = *(const u32x4*)(TB + (size_t)(chunk_ * 128 + b) * DM + 256 * grp_ + 128 * kin + ch * 8); } } while (0)
    if ((int)blockIdx.x < 2560) P3_LOAD((int)blockIdx.x);
    for (int u = blockIdx.x; u < 2560; u += G) {
        const int chunk = u >> 2, grp = u & 3;
#pragma unroll
        for (int i = 0; i < 8; ++i) { const int idx = tid + NTHR * i, ch = idx & 15, kp = idx >> 4; *(LAS u32x4*)(lds + kp * 288 + ch * 16) = xr[i]; }
        __syncthreads();
        if (u + G < 2560) P3_LOAD(u + G);
        f32x4 acc[1][8];
#pragma unroll
        for (int n = 0; n < 8; ++n) acc[0][n] = (f32x4){0.f, 0.f, 0.f, 0.f};
        mix_mma<1, 8>(acc, wf, lds, 288, 0, lane);
        int seq0, Na, ka;
        if (chunk < 128) { seq0 = 0; Na = 128; ka = chunk; } else { const int cs = chunk - 128; seq0 = 16384 + 8192 * (cs >> 6); Na = 64; ka = cs & 63; }
        const int kb = 16 * w + fr; const size_t row = (size_t)seq0 + ka + (size_t)Na * kb;
        bf16_t* op = CAT + row * DM + 128 * grp + 4 * g4;
#pragma unroll
        for (int n = 0; n < 8; ++n) { const f32x4 v = acc[0][n]; u32x2 o; o.x = cvt_pk_bf16(v[0], v[1]); o.y = cvt_pk_bf16(v[2], v[3]); *(u32x2*)(op + 16 * n) = o; }
        __syncthreads();
    }
#undef P3_LOAD
}

__device__ void p5_rows(const Params& P, int G, const Part pt) {
    const int tid = threadIdx.x, lane = tid & 63, wave = tid >> 6;
    unsigned char* ws = P.ws;
    const bf16_t* MB = (const bf16_t*)(ws + WS_M); const float* SSQ = (const float*)(ws + WS_SSQM); bf16_t* H2 = (bf16_t*)(ws + WS_H2);
    { const u32x4 z = {0u, 0u, 0u, 0u};
      if (pt.px == 0) for (long it = (long)pt.rank * NTHR + tid; it < 256L * 128; it += (long)pt.nb * NTHR) { const long r = it >> 7, c = it & 127; *(u32x4*)(H2 + (r - 256) * DM + c * 8) = z; }
      if (pt.px == pt.nx - 1) for (long it = (long)pt.rank * NTHR + tid; it < 256L * 128; it += (long)pt.nb * NTHR) { const long r = it >> 7, c = it & 127; *(u32x4*)(H2 + ((long)MTOK + r) * DM + c * 8) = z; } }
    f32x4 gm[4];
#pragma unroll
    for (int i = 0; i < 4; ++i) gm[i] = *(const f32x4*)(P.post_mix_norm + i * 256 + lane * 4);
    const bf16_t* H0 = (const bf16_t*)(ws + WS_H0); const float* IRS0 = (const float*)(ws + WS_SSQC);
    for (int r = pt.r0 + pt.rank * 8 + wave; r < pt.r1; r += pt.nb * 16) {
        int rw[2]; rw[0] = r; rw[1] = (r + pt.nb * 8 < pt.r1) ? r + pt.nb * 8 : r;
        u32x2 hw[2][4], mw[2][4]; float ssq[2], irs0[2];
#pragma unroll
        for (int q = 0; q < 2; ++q) { const size_t ro = (size_t)rw[q];
#pragma unroll
            for (int i = 0; i < 4; ++i) { hw[q][i] = *(const u32x2*)(H0 + ro * DM + i * 256 + lane * 4); mw[q][i] = *(const u32x2*)(MB + ro * DM + i * 256 + lane * 4); }
            ssq[q] = sum16(SSQ + ro * 16); irs0[q] = IRS0[ro * 16]; }
#pragma unroll
        for (int q = 0; q < 2; ++q) { const size_t ro = (size_t)rw[q];
            const float rsm = rsqrtf(ssq[q] * (1.0f / 1024.0f) + EPS), ir = irs0[q];
            f32x4 v[4]; float s = 0.f;
#pragma unroll
            for (int i = 0; i < 4; ++i) {
                v[i][0] = bf_lo(hw[q][i].x) * ir + bf_lo(mw[q][i].x) * rsm * gm[i][0]; v[i][1] = bf_hi(hw[q][i].x) * ir + bf_hi(mw[q][i].x) * rsm * gm[i][1];
                v[i][2] = bf_lo(hw[q][i].y) * ir + bf_lo(mw[q][i].y) * rsm * gm[i][2]; v[i][3] = bf_hi(hw[q][i].y) * ir + bf_hi(mw[q][i].y) * rsm * gm[i][3];
                s += (v[i][0] * v[i][0] + v[i][1] * v[i][1]) + (v[i][2] * v[i][2] + v[i][3] * v[i][3]); }
#pragma unroll
            for (int o = 1; o < 64; o <<= 1) s += __shfl_xor(s, o);
            const float rs = rsqrtf(s * (1.0f / 1024.0f) + EPS);
            if (lane == 0) ((float*)SSQ)[ro * 16] = 1.0f / rs;
#pragma unroll
            for (int i = 0; i < 4; ++i) { u32x2 w; w.x = cvt_pk_bf16(v[i][0] * rs, v[i][1] * rs); w.y = cvt_pk_bf16(v[i][2] * rs, v[i][3] * rs);
                *(u32x2*)(H2 + ro * DM + i * 256 + lane * 4) = w; }
        }
    }
}
__device__ void p8_rows(const Params& P, int G, const Part pt) {
    const int tid = threadIdx.x, lane = tid & 63, wave = tid >> 6;
    unsigned char* ws = P.ws;
    const bf16_t* CB = (const bf16_t*)(ws + WS_C); const float* SSQ = (const float*)(ws + WS_SSQC); const bf16_t* H2 = (const bf16_t*)(ws + WS_H2); const float* IRS = (const float*)(ws + WS_SSQM);
    f32x4 gm[4];
#pragma unroll
    for (int i = 0; i < 4; ++i) gm[i] = *(const f32x4*)(P.post_ffn_norm + i * 256 + lane * 4);
    for (int r = pt.r0 + pt.rank * 8 + wave; r < pt.r1; r += pt.nb * 8) {
        const f32x4 s0 = *(const f32x4*)(SSQ + (size_t)r * 16), s1 = *(const f32x4*)(SSQ + (size_t)r * 16 + 4), s2 = *(const f32x4*)(SSQ + (size_t)r * 16 + 8), s3 = *(const f32x4*)(SSQ + (size_t)r * 16 + 12);
        const float ssq = ((s0[0] + s0[1]) + (s0[2] + s0[3])) + ((s1[0] + s1[1]) + (s1[2] + s1[3])) + ((s2[0] + s2[1]) + (s2[2] + s2[3])) + ((s3[0] + s3[1]) + (s3[2] + s3[3]));
        const float rsm = rsqrtf(ssq * (1.0f / 1024.0f) + EPS); const float irs = IRS[(size_t)r * 16];
#pragma unroll
        for (int i = 0; i < 4; ++i) { const u32x2 hw = *(const u32x2*)(H2 + (size_t)r * DM + i * 256 + lane * 4); const u32x2 cw = *(const u32x2*)(CB + (size_t)r * DM + i * 256 + lane * 4);
            f32x4 xv;
            xv[0] = bf_lo(hw.x) * irs + bf_lo(cw.x) * rsm * gm[i][0]; xv[1] = bf_hi(hw.x) * irs + bf_hi(cw.x) * rsm * gm[i][1];
            xv[2] = bf_lo(hw.y) * irs + bf_lo(cw.y) * rsm * gm[i][2]; xv[3] = bf_hi(hw.y) * irs + bf_hi(cw.y) * rsm * gm[i][3];
            *(f32x4*)(P.out + (size_t)r * DM + i * 256 + lane * 4) = xv; }
    }
}


#ifdef DIAG_CHK
__device__ const int chk_rows[24] = {0, 1, 61, 62, 63, 127, 128, 247, 248, 255, 256, 8191, 8192, 16383, 16384, 16385, 24575, 24576, 40000, 65535, 65536, 81791, 81918, 81919};
constexpr int NCHK = 24;
__device__ __forceinline__ float bf2f(bf16_t b) { return __uint_as_float(((unsigned)b) << 16); }
__device__ __forceinline__ float gelu_ref(float x) { return 0.5f * x * (1.0f + tanhf(0.7978845608f * (x + 0.044715f * x * x * x))); }
__device__ __forceinline__ bool bad(float got, float ref, float rel, float ab) { return !(fabsf(got - ref) <= rel * fabsf(ref) + ab); }
__device__ float block_sum(float v, LAS float* red) {
    for (int o = 1; o < 64; o <<= 1) v += __shfl_xor(v, o);
    __syncthreads();
    if ((threadIdx.x & 63) == 0) red[threadIdx.x >> 6] = v;
    __syncthreads();
    float t = 0.f; for (int i = 0; i < NTHR / 64; ++i) t += red[i];
    __syncthreads();
    return t;
}
__device__ void chk_p1(const Params& P, LAS unsigned char* lds, unsigned* flags) {
    if (blockIdx.x >= NCHK) return;
    const int r = chk_rows[blockIdx.x], tid = threadIdx.x; unsigned char* ws = P.ws;
    LAS float* red = (LAS float*)lds; LAS float* hn = red + 16; LAS float* z = hn + 1024;
    const float* xp = xrow(P, r);
    float s = 0.f; for (int k = tid; k < 1024; k += NTHR) s += xp[k] * xp[k];
    s = block_sum(s, red); const float rs = rsqrtf(s / 1024.0f + EPS);
    for (int k = tid; k < 1024; k += NTHR) hn[k] = xp[k] * rs * P.pre_mix_norm[k];
    __syncthreads();
    for (int c = tid; c < 1536; c += NTHR) { float a = 0.f; for (int k = 0; k < 1024; ++k) a += hn[k] * P.w_in[(size_t)k * 1536 + c]; z[c] = a; }
    __syncthreads();
    const bf16_t* YB = (const bf16_t*)(ws + WS_Y); const bf16_t* UB = (const bf16_t*)(ws + WS_U); const bf16_t* VB = (const bf16_t*)(ws + WS_V);
    bool b1 = false, b2 = false;
    for (int n = tid; n < 1024; n += NTHR) { const int grp = n >> 8, im = (n >> 7) & 1, l = n & 127; float a = 0.f;
        for (int c = 0; c < 128; ++c) a += z[128 * grp + c] * cospif((float)((l * c + 32 * im) & 127) / 64.0f);
        a *= 0.08838834764831845f; if (bad(bf2f(YB[(size_t)r * 1024 + n]), a, 0.03f, 0.03f)) b1 = true; }
    for (int j = tid; j < 512; j += NTHR) { if (bad(bf2f(UB[(size_t)r * 512 + j]), gelu_ref(z[512 + j]), 0.03f, 0.03f)) b2 = true; if (bad(bf2f(VB[(size_t)r * 512 + j]), gelu_ref(z[1024 + j]), 0.03f, 0.03f)) b2 = true; }
    if (b1) flags[1] = 1u; if (b2) flags[2] = 1u;
}
__device__ void chk_p3(const Params& P, LAS unsigned char* lds, unsigned* flags) {
    if (blockIdx.x >= NCHK) return;
    const int r = chk_rows[blockIdx.x], tid = threadIdx.x; unsigned char* ws = P.ws;
    const bf16_t* YB = (const bf16_t*)(ws + WS_Y); const bf16_t* UB = (const bf16_t*)(ws + WS_U); const bf16_t* VB = (const bf16_t*)(ws + WS_V); const bf16_t* CAT = (const bf16_t*)(ws + WS_CAT);
    { const int seq0 = r < 16384 ? 0 : 16384 + ((r - 16384) >> 13) * 8192, S = r < 16384 ? 16384 : 8192, k = r - seq0; const int grp = tid >> 7, l = tid & 127;
      float a = 0.f;
      for (int sidx = 0; sidx < S; ++sidx) { const unsigned ph = ((unsigned)k * (unsigned)sidx) & (unsigned)(S - 1); float sn, cs; sincospif(2.0f * (float)ph / (float)S, &sn, &cs);
          const bf16_t* yp = YB + (size_t)(seq0 + sidx) * 1024 + 256 * grp + l; a += bf2f(yp[0]) * cs + bf2f(yp[128]) * sn; }
      a *= rsqrtf((float)S);
      if (bad(bf2f(CAT[(size_t)r * 1024 + 128 * grp + l]), a, 0.03f, 0.03f)) flags[3] = 1u; }
    { LAS float* rsq = (LAS float*)lds; const int chunk = r >> 7, p = r & 127;
      { const int q = tid >> 2, h = tid & 3; float ss = 0.f; for (int c = 0; c < 128; ++c) { const float v = bf2f(VB[(size_t)(chunk * 128 + q) * 512 + 128 * h + c]); ss += v * v; } rsq[q * 4 + h] = rsqrtf(ss / 128.0f + EPS); }
      __syncthreads();
      const int h = tid >> 7, c = tid & 127; float sv = 0.f;
      for (int q = 0; q < 128; ++q) sv += P.w_spatial[(h * 128 + p) * 128 + q] * bf2f(VB[(size_t)(chunk * 128 + q) * 512 + 128 * h + c]) * rsq[q * 4 + h] * P.sgu_norm[h * 128 + c];
      const float gval = bf2f(UB[(size_t)r * 512 + 128 * h + c]) * (sv + P.b_spatial[h * 128 + p]);
      if (bad(bf2f(CAT[(size_t)r * 1024 + 512 + 128 * h + c]), gval, 0.03f, 0.03f)) flags[4] = 1u;
      __syncthreads(); }
}
__device__ void chk_p4(const Params& P, LAS unsigned char* lds, unsigned* flags) {
    if (blockIdx.x >= NCHK) return;
    const int r = chk_rows[blockIdx.x], tid = threadIdx.x; unsigned char* ws = P.ws;
    const bf16_t* CAT = (const bf16_t*)(ws + WS_CAT); const bf16_t* MB = (const bf16_t*)(ws + WS_M); const float* SSQ = (const float*)(ws + WS_SSQM);
    LAS float* red = (LAS float*)lds; float sq = 0.f;
    for (int n = tid; n < 1024; n += NTHR) { float a = 0.f; for (int k = 0; k < 1024; ++k) a += bf2f(CAT[(size_t)r * 1024 + k]) * P.w_out[(size_t)k * 1024 + n];
        if (bad(bf2f(MB[(size_t)r * 1024 + n]), a, 0.03f, 0.03f)) flags[5] = 1u; sq += a * a; }
    sq = block_sum(sq, red); float s2 = 0.f; for (int i = 0; i < 16; ++i) s2 += SSQ[(size_t)r * 16 + i];
    if (bad(s2, sq, 0.03f, 0.01f)) flags[6] = 1u;
}
__device__ void chk_p5(const Params& P, LAS unsigned char* lds, unsigned* flags) {
    if (blockIdx.x >= NCHK) return;
    const int r = chk_rows[blockIdx.x], tid = threadIdx.x; unsigned char* ws = P.ws;
    const bf16_t* MB = (const bf16_t*)(ws + WS_M); const bf16_t* H2 = (const bf16_t*)(ws + WS_H2);
    LAS float* red = (LAS float*)lds; const float* xp = xrow(P, r);
    float sq = 0.f; for (int n = tid; n < 1024; n += NTHR) { const float m = bf2f(MB[(size_t)r * 1024 + n]); sq += m * m; }
    sq = block_sum(sq, red); const float rsm = rsqrtf(sq / 1024.0f + EPS);
    float x1[2]; float s1 = 0.f;
    for (int i = 0; i < 2; ++i) { const int n = tid + i * NTHR; x1[i] = xp[n] + bf2f(MB[(size_t)r * 1024 + n]) * rsm * P.post_mix_norm[n]; s1 += x1[i] * x1[i];
        if (bad(P.out[(size_t)r * 1024 + n], x1[i], 0.02f, 0.02f)) flags[7] = 1u; }
    s1 = block_sum(s1, red); const float rs2 = rsqrtf(s1 / 1024.0f + EPS);
    for (int i = 0; i < 2; ++i) { const int n = tid + i * NTHR; if (bad(bf2f(H2[(size_t)r * 1024 + n]), x1[i] * rs2, 0.03f, 0.03f)) flags[8] = 1u; }
}
__device__ void chk_p6(const Params& P, LAS unsigned char* lds, unsigned* flags) {
    if (blockIdx.x >= NCHK) return;
    const int r = chk_rows[blockIdx.x], tid = threadIdx.x; unsigned char* ws = P.ws;
    const bf16_t* H2 = (const bf16_t*)(ws + WS_H2); const bf16_t* HID = (const bf16_t*)(ws + WS_HID);
    LAS float* hh = (LAS float*)lds;
    const bool first = (r == 0) || (r >= 16384 && (r & 8191) == 0), last = ((r + 1) >= 16384 && ((r + 1) & 8191) == 0);
    for (int i = tid; i < 3072; i += NTHR) { const int d = i >> 10, k = i & 1023; const bool ok = (d == 1) || (d == 0 && !first) || (d == 2 && !last);
        hh[i] = ok ? bf2f(H2[(size_t)(r + d - 1) * 1024 + k]) * P.pre_ffn_norm[k] : 0.f; }
    __syncthreads();
    for (int j = tid; j < DFF; j += NTHR) { float g[3] = {0.f, 0.f, 0.f}, u[3] = {0.f, 0.f, 0.f};
        for (int k = 0; k < 1024; ++k) { const float wg = P.w_up[(size_t)k * N3 + j], wu = P.w_up[(size_t)k * N3 + DFF + j];
            g[0] += hh[k] * wg; g[1] += hh[1024 + k] * wg; g[2] += hh[2048 + k] * wg; u[0] += hh[k] * wu; u[1] += hh[1024 + k] * wu; u[2] += hh[2048 + k] * wu; }
        const float gv = g[0] * P.conv_w[j] + g[1] * P.conv_w[N3 + j] + g[2] * P.conv_w[2 * N3 + j] + P.conv_b[j];
        const float uv = u[0] * P.conv_w[DFF + j] + u[1] * P.conv_w[N3 + DFF + j] + u[2] * P.conv_w[2 * N3 + DFF + j] + P.conv_b[DFF + j];
        if (bad(bf2f(HID[(size_t)r * DFF + j]), gelu_ref(gv) * uv, 0.04f, 0.04f)) flags[9] = 1u; }
    __syncthreads();
}
__device__ void chk_p7(const Params& P, LAS unsigned char* lds, unsigned* flags) {
    if (blockIdx.x >= NCHK) return;
    const int r = chk_rows[blockIdx.x], tid = threadIdx.x; unsigned char* ws = P.ws;
    const bf16_t* HID = (const bf16_t*)(ws + WS_HID); const bf16_t* CB = (const bf16_t*)(ws + WS_C);
    for (int n = tid; n < 1024; n += NTHR) { float a = 0.f; for (int k = 0; k < DFF; ++k) a += bf2f(HID[(size_t)r * DFF + k]) * P.w_down[(size_t)k * 1024 + n];
        if (bad(bf2f(CB[(size_t)r * 1024 + n]), a, 0.03f, 0.03f)) flags[10] = 1u; }
}
#endif
__device__ __forceinline__ void grid_barrier(unsigned* cnt, unsigned target) {
    asm volatile("s_waitcnt vmcnt(0) lgkmcnt(0)" ::: "memory");
    __syncthreads();
    if (threadIdx.x == 0) {
        __builtin_amdgcn_fence(__ATOMIC_RELEASE, "agent");
        asm volatile("s_waitcnt vmcnt(0)" ::: "memory");
        __hip_atomic_fetch_add(cnt, 1u, __ATOMIC_RELAXED, __HIP_MEMORY_SCOPE_AGENT);
        while (__hip_atomic_load(cnt, __ATOMIC_RELAXED, __HIP_MEMORY_SCOPE_AGENT) < target) __builtin_amdgcn_s_sleep(1);
        __builtin_amdgcn_fence(__ATOMIC_ACQUIRE, "agent");
        asm volatile("s_waitcnt vmcnt(0)" ::: "memory");
    }
    __syncthreads();
}
__device__ __forceinline__ void nbr_barrier(unsigned* base, int px, int nx, unsigned target) {
    asm volatile("s_waitcnt vmcnt(0) lgkmcnt(0)" ::: "memory");
    __syncthreads();
    if (threadIdx.x == 0) {
        __builtin_amdgcn_fence(__ATOMIC_RELEASE, "agent");
        asm volatile("s_waitcnt vmcnt(0)" ::: "memory");
        __hip_atomic_fetch_add(base + 64 * px, 1u, __ATOMIC_RELAXED, __HIP_MEMORY_SCOPE_AGENT);
        while (__hip_atomic_load(base + 64 * px, __ATOMIC_RELAXED, __HIP_MEMORY_SCOPE_AGENT) < target) __builtin_amdgcn_s_sleep(1);
        if (px > 0) while (__hip_atomic_load(base + 64 * (px - 1), __ATOMIC_RELAXED, __HIP_MEMORY_SCOPE_AGENT) < target) __builtin_amdgcn_s_sleep(1);
        if (px + 1 < nx) while (__hip_atomic_load(base + 64 * (px + 1), __ATOMIC_RELAXED, __HIP_MEMORY_SCOPE_AGENT) < target) __builtin_amdgcn_s_sleep(1);
        __builtin_amdgcn_fence(__ATOMIC_ACQUIRE, "agent");
        asm volatile("s_waitcnt vmcnt(0)" ::: "memory");
    }
    __syncthreads();
}
__device__ __forceinline__ void grid_barrier2(unsigned* base, int px, int nx, unsigned nb, unsigned phase) {
    asm volatile("s_waitcnt vmcnt(0) lgkmcnt(0)" ::: "memory");
    __syncthreads();
    if (threadIdx.x == 0) {
        __builtin_amdgcn_fence(__ATOMIC_RELEASE, "agent");
        asm volatile("s_waitcnt vmcnt(0)" ::: "memory");
        unsigned* xa = base + 2560 + 64 * px; unsigned* top = base + 3072; unsigned* gen = base + 3136;
        const unsigned old = __hip_atomic_fetch_add(xa, 1u, __ATOMIC_RELAXED, __HIP_MEMORY_SCOPE_AGENT);
        if (old == nb * phase - 1u) {
            const unsigned t = __hip_atomic_fetch_add(top, 1u, __ATOMIC_RELAXED, __HIP_MEMORY_SCOPE_AGENT);
            if (t == (unsigned)nx * phase - 1u) for (int q = 0; q < nx; ++q) __hip_atomic_store(gen + 64 * q, phase, __ATOMIC_RELAXED, __HIP_MEMORY_SCOPE_AGENT);
        }
        while (__hip_atomic_load(gen + 64 * px, __ATOMIC_RELAXED, __HIP_MEMORY_SCOPE_AGENT) < phase) __builtin_amdgcn_s_sleep(1);
        __builtin_amdgcn_fence(__ATOMIC_ACQUIRE, "agent");
        asm volatile("s_waitcnt vmcnt(0)" ::: "memory");
    }
    __syncthreads();
}
#define GRID_SYNC1() do { ++bar1_phase; grid_barrier(bar_cnt, (unsigned)G * bar1_phase); } while (0)
#define GRID_SYNC() do { ++bar_phase; grid_barrier2(bar_cnt, pt.px, pt.nx, (unsigned)pt.nb, bar_phase); } while (0)
__device__ void cksum(const unsigned char* p, size_t nbytes, unsigned long long* slot, int G) {
    unsigned long long s = 0;
    for (size_t i = (size_t)blockIdx.x * NTHR + threadIdx.x; i < nbytes / 16; i += (size_t)G * NTHR) { const u32x4 v = *(const u32x4*)(p + i * 16); s += (unsigned long long)v.x + v.y + v.z + v.w; }
    for (int o = 1; o < 64; o <<= 1) { const unsigned lo = __shfl_xor((unsigned)s, o), hi = __shfl_xor((unsigned)(s >> 32), o); s += ((unsigned long long)hi << 32) | lo; }
    if ((threadIdx.x & 63) == 0) __hip_atomic_fetch_add(slot, s, __ATOMIC_RELAXED, __HIP_MEMORY_SCOPE_AGENT);
}
__global__ void __launch_bounds__(NTHR, 2) fwd_megakernel(Params P) {
    extern __shared__ __attribute__((aligned(16))) unsigned char lds_raw[];
    LAS unsigned char* lds = (LAS unsigned char*)lds_raw;
    cg::grid_group grid = cg::this_grid();
    const int G = gridDim.x;
    unsigned char* ws = P.ws;
    unsigned* bar_cnt = (unsigned*)(ws + WS_BAR); unsigned bar_phase = 0, pbar_phase = 0, bar1_phase = 0; (void)bar1_phase;
    if (P.never) grid.sync();

    const int lo = P.ph_lo, hi = P.ph_hi;
#define IN(k) (lo <= (k) && (k) < hi)
#define SEAM(k) do { if (IN(k) && IN((k) + 1)) GRID_SYNC(); } while (0)
#define NSEAM(k) do { if (IN(k) && IN((k) + 1)) { ++pbar_phase; nbr_barrier(bar_cnt + 2048, pt.px, pt.nx, (unsigned)pt.nb * pbar_phase); } } while (0)
#define PSEAM(k) do { if (IN(k) && IN((k) + 1)) { ++pbar_phase; grid_barrier(bar_cnt + 2048 + 64 * pt.px, (unsigned)pt.nb * pbar_phase); } } while (0)
    Part pt;
    if (P.census) {
        unsigned* xc = (unsigned*)(ws + WS_BAR + 1024);
        LAS unsigned* lw = (LAS unsigned*)lds;
        if (threadIdx.x == 0) {
            const unsigned xcc = (unsigned)__builtin_amdgcn_s_getreg((3 << 11) | 20) & 0xFu;
            lw[0] = xcc; lw[1] = __hip_atomic_fetch_add(xc + 16 * xcc, 1u, __ATOMIC_RELAXED, __HIP_MEMORY_SCOPE_AGENT);
        }
        GRID_SYNC1();
        const unsigned xcc = lw[0], rank = lw[1];
        int nx = 0, px = 0, nb = 1;
        for (unsigned jx = 0; jx < 16; ++jx) { const unsigned c = __hip_atomic_load(xc + 16 * jx, __ATOMIC_RELAXED, __HIP_MEMORY_SCOPE_AGENT); if (c) { if (jx < xcc) ++px; ++nx; } if (jx == xcc) nb = (int)c; }
        const int t0 = (320 * px) / nx, t1 = (320 * (px + 1)) / nx;
        pt.r0 = __builtin_amdgcn_readfirstlane(t0 * 256); pt.r1 = __builtin_amdgcn_readfirstlane(t1 * 256);
        pt.nb = __builtin_amdgcn_readfirstlane(nb); pt.rank = __builtin_amdgcn_readfirstlane((int)rank); pt.px = __builtin_amdgcn_readfirstlane(px); pt.nx = __builtin_amdgcn_readfirstlane(nx);
        __syncthreads();
    } else {
        const int nx = (G % 8 == 0) ? 8 : 1, px = (int)blockIdx.x % nx;
        pt.r0 = ((320 * px) / nx) * 256; pt.r1 = ((320 * (px + 1)) / nx) * 256; pt.nb = G / nx; pt.rank = (int)blockIdx.x / nx; pt.px = px; pt.nx = nx;
    }
    const int nMp = (pt.r1 - pt.r0) >> 8;

    if (IN(0)) p0_prep(P, lds, G, pt);
    SEAM(0);
    if (IN(1)) {
        pg8::Gemm g{(const bf16_t*)(ws + WS_H0), (const bf16_t*)(ws + WS_W1T), DM};
        pg8::PartOrder S{pt.r0, 256, nMp, N1 / 256, pt.nb, pt.rank};
        EpiZ E{(bf16_t*)P.out, (bf16_t*)(ws + WS_U), (bf16_t*)(ws + WS_V)};
        pg8::gemm_phase<EpiZ, false>(lds, g, S, E);
    }
    SEAM(1);
    if (IN(2)) p2_mix(P, lds, G, pt);
    SEAM(2);
    if (IN(3)) p3_dft2(P, lds, G);
    SEAM(3);
    if (IN(4)) {
        pg8::Gemm g{(const bf16_t*)(ws + WS_CAT), (const bf16_t*)(ws + WS_W2T), DM};
        pg8::PartOrder S{pt.r0, 256, nMp, DM / 256, pt.nb, pt.rank};
        EpiMS E{(bf16_t*)(ws + WS_M), (float*)(ws + WS_SSQM)};
        pg8::gemm_phase<EpiMS, false>(lds, g, S, E);
    }
    PSEAM(4);
    if (IN(5)) p5_rows(P, G, pt);
    NSEAM(5);
    if (IN(6)) {
        pg8::Gemm g{(const bf16_t*)(ws + WS_H2), (const bf16_t*)(ws + WS_W3T), DM};
        pg8::PartOrder S{pt.r0, 248, (pt.r1 - pt.r0 + 247) / 248, N3 / 256, pt.nb, pt.rank};
        EpiFFN E{(bf16_t*)(ws + WS_HID), P.conv_w, P.conv_b, pt.r1};
        pg8::gemm_phase<EpiFFN, true>(lds, g, S, E);
    }
    PSEAM(6);
    const bool fuse_ok = (pt.nb % 32 == 0) && (nMp % 8 == 0) && (lo == 0) && (hi == 9);
    if (IN(7)) {
        pg8::Gemm g{(const bf16_t*)(ws + WS_HID), (const bf16_t*)(ws + WS_W4T), DFF};
        pg8::PartOrder S{pt.r0, 256, nMp, DM / 256, pt.nb, pt.rank};
        if (fuse_ok) {
            EpiY E{P.out, (const bf16_t*)(ws + WS_H2), (const float*)(ws + WS_SSQM), (float*)(ws + WS_SSQC), (unsigned*)(ws + WS_BAR + 4096), P.post_ffn_norm};
            pg8::gemm_phase<EpiY, false>(lds, g, S, E);
        } else {
            EpiMS E{(bf16_t*)(ws + WS_C), (float*)(ws + WS_SSQC)};
            pg8::gemm_phase<EpiMS, false>(lds, g, S, E);
        }
    }
    if (!fuse_ok) SEAM(7);
#ifdef DIAG_DET
    if (P.ck >= 0) {
        unsigned long long* slots = (unsigned long long*)(ws + WS_BAR + 4096);
        GRID_SYNC();
        const unsigned char* p1 = ws; size_t n1 = 0; const unsigned char* p2 = ws; size_t n2 = 0;
        switch (lo) {
            case 0: p1 = ws; n1 = WS_BAR; p2 = ws + WS_H0; n2 = ACT; break;
            case 1: p1 = (const unsigned char*)P.out; n1 = ACT; p2 = ws + WS_U; n2 = ACT; break;
            case 2: p1 = (const unsigned char*)P.out + ACT; n1 = ACT; break;
            case 3: p1 = ws + WS_CAT; n1 = ACT; break;
            case 4: p1 = ws + WS_M; n1 = ACT; p2 = ws + WS_SSQM; n2 = 5 * MiB; break;
            case 5: p1 = ws + WS_H2R; n1 = 161 * MiB; p2 = (const unsigned char*)P.out; n2 = 2 * ACT; break;
            case 6: p1 = ws + WS_HID; n1 = 440 * MiB; break;
            case 7: p1 = ws + WS_C; n1 = ACT; p2 = ws + WS_SSQC; n2 = 5 * MiB; break;
            default: break;
        }
        cksum(p1, n1, slots + 2 * lo + P.ck, G); cksum(p2, n2, slots + 32 + 2 * lo + P.ck, G);
    }
    if (IN(8)) {
        const unsigned long long* slots = (const unsigned long long*)(ws + WS_BAR + 4096); int code = 0;
        for (int k = 7; k >= 0; --k) { if (slots[32 + 2 * k] != slots[32 + 2 * k + 1]) code = 2 * k + 2; if (slots[2 * k] != slots[2 * k + 1]) code = 2 * k + 1; }
        if (code) { const float al = (float)(code + 2);
            for (size_t i = (size_t)blockIdx.x * NTHR + threadIdx.x; i < (size_t)MTOK * DM; i += (size_t)G * NTHR) { const int r = (int)(i >> 10), c = (int)(i & 1023); P.out[i] = al * xrow(P, r)[c]; }
            return; }
    }
#endif
    if (IN(8) && !fuse_ok) p8_rows(P, G, pt);
#undef IN
#undef SEAM
}

extern "C" void kernel_launch(void* const* d_in, const int* in_sizes, int n_in, void* d_out, int out_size, void* d_ws, size_t ws_size, hipStream_t stream) {
    static int grid_blocks = 0;
    if (grid_blocks == 0) {
        if (n_in != 15 || ws_size < WS_END) { fprintf(stderr, "kernel_launch: unexpected n_in %d or ws_size %zu (< %zu)\n", n_in, ws_size, (size_t)WS_END); grid_blocks = -1; return; }
        int dev = 0, cus = 0, per_cu = 0;
        (void)hipGetDevice(&dev);
        (void)hipDeviceGetAttribute(&cus, hipDeviceAttributeMultiprocessorCount, dev);
        if (hipFuncSetAttribute((const void*)fwd_megakernel, hipFuncAttributeMaxDynamicSharedMemorySize, LDS_BYTES) != hipSuccess) { fprintf(stderr, "kernel_launch: hipFuncSetAttribute failed\n"); grid_blocks = -1; return; }
        if (hipOccupancyMaxActiveBlocksPerMultiprocessor(&per_cu, (const void*)fwd_megakernel, NTHR, LDS_BYTES) != hipSuccess || per_cu < 1) { fprintf(stderr, "kernel_launch: occupancy query gave %d\n", per_cu); grid_blocks = -1; return; }
        grid_blocks = cus * per_cu;
    }
    if (grid_blocks < 0) return;
    Params p{};
    p.x_prompt = (const float*)d_in[0]; p.x_sample = (const float*)d_in[1]; p.pre_mix_norm = (const float*)d_in[2]; p.w_in = (const float*)d_in[3]; p.sgu_norm = (const float*)d_in[4];
    p.w_spatial = (const float*)d_in[5]; p.b_spatial = (const float*)d_in[6]; p.w_out = (const float*)d_in[7]; p.post_mix_norm = (const float*)d_in[8]; p.pre_ffn_norm = (const float*)d_in[9];
    p.w_up = (const float*)d_in[10]; p.conv_w = (const float*)d_in[11]; p.conv_b = (const float*)d_in[12]; p.w_down = (const float*)d_in[13]; p.post_ffn_norm = (const float*)d_in[14];
    p.out = (float*)d_out; p.ws = (unsigned char*)d_ws;
    p.never = 0;
    hipError_t e = hipSuccess;
#if N_LAUNCHES == 1
    p.census = 0; p.ph_lo = 0; p.ph_hi = 9; p.ck = -1;
    (void)hipMemsetAsync((char*)d_ws + WS_BAR, 0, 16384, stream);
    { void* args[] = {&p}; e = hipLaunchCooperativeKernel((const void*)fwd_megakernel, dim3(grid_blocks), dim3(NTHR), args, LDS_BYTES, stream); }
#else
    (void)hipMemsetAsync((char*)d_ws + WS_BAR, 0, 16384, stream);
    for (int k = 0; k < 9 && e == hipSuccess; ++k) {
#ifdef DIAG_DET
        for (int rep = 0; rep < (k < 8 ? 2 : 1); ++rep) {
            (void)hipMemsetAsync((char*)d_ws + WS_BAR, 0, 1024, stream);
            p.census = 0; p.ph_lo = k; p.ph_hi = k + 1; p.ck = (k < 8) ? rep : -1;
            void* args[] = {&p}; e = hipLaunchCooperativeKernel((const void*)fwd_megakernel, dim3(grid_blocks), dim3(NTHR), args, LDS_BYTES, stream);
        }
#else
        p.census = 0; p.ph_lo = k; p.ph_hi = k + 1; p.ck = -1;
        void* args[] = {&p}; e = hipLaunchCooperativeKernel((const void*)fwd_megakernel, dim3(grid_blocks), dim3(NTHR), args, LDS_BYTES, stream);
#endif
    }
#endif
    if (e != hipSuccess) fprintf(stderr, "cooperative launch failed: %s (grid %d)\n", hipGetErrorString(e), grid_blocks);
}
```

```cpp
#define N_LAUNCHES 1

#include <hip/hip_runtime.h>
#include <hip/hip_cooperative_groups.h>
#include <cstdio>
namespace cg = cooperative_groups;

#define LAS __attribute__((address_space(3)))
typedef unsigned short bf16_t;
typedef short bf16x8 __attribute__((ext_vector_type(8)));
typedef short bf16x4 __attribute__((ext_vector_type(4)));
typedef float f32x4 __attribute__((ext_vector_type(4)));
typedef float f32x2 __attribute__((ext_vector_type(2)));
typedef unsigned u32x4 __attribute__((ext_vector_type(4)));
typedef unsigned u32x2 __attribute__((ext_vector_type(2)));

constexpr int MTOK = 81920, DM = 1024, DFF = 2816, N1 = 1536, N3 = 5632;
constexpr int NTHR = 512;
constexpr float EPS = 1e-6f;

constexpr size_t MiB = 1024ull * 1024ull;
constexpr size_t WS_W1T = 0;
constexpr size_t WS_W2T = WS_W1T + 4 * MiB;
constexpr size_t WS_W3T = WS_W2T + 2 * MiB;
constexpr size_t WS_W4T = WS_W3T + 11 * MiB;
constexpr size_t WS_WSP = WS_W4T + 6 * MiB;
constexpr size_t WS_WA128 = WS_WSP + 128 * 1024;
constexpr size_t WS_WA64 = WS_WA128 + 128 * 1024;
constexpr size_t WS_WB = WS_WA64 + 32 * 1024;
constexpr size_t WS_TW = WS_WB + 64 * 1024;
constexpr size_t WS_WC = WS_TW + 128 * 1024;
constexpr size_t WS_BAR = 24 * MiB - 16384;
constexpr size_t WS_SSQM = 24 * MiB;
constexpr size_t WS_SSQC = 29 * MiB;
constexpr size_t ACT = (size_t)MTOK * DM * 2;
constexpr size_t WS_CAT = 34 * MiB;
constexpr size_t WS_C = WS_CAT;
constexpr size_t WS_H2R = WS_CAT + 160 * MiB;
constexpr size_t WS_H2 = WS_H2R + 256 * DM * 2;
constexpr size_t WS_BIG = WS_H2R + 161 * MiB;
constexpr size_t WS_H0 = WS_BIG, WS_U = WS_BIG + ACT, WS_V = WS_BIG + ACT + ACT / 2, WS_HID = WS_BIG;
constexpr size_t WS_M = WS_BIG + 440 * MiB;
constexpr size_t WS_END = WS_M + 160 * MiB;

constexpr int LDS_BYTES = 144 * 1024;

typedef __bf16 bf16x2_t __attribute__((ext_vector_type(2)));
__device__ __forceinline__ unsigned cvt_pk_bf16(float lo, float hi) { const f32x2 v = {lo, hi}; const bf16x2_t b = __builtin_convertvector(v, bf16x2_t); return __builtin_bit_cast(unsigned, b); }
__device__ __forceinline__ float bf_lo(unsigned w) { return __uint_as_float(w << 16); }
__device__ __forceinline__ float bf_hi(unsigned w) { return __uint_as_float(w & 0xffff0000u); }
__device__ __forceinline__ float gelu_f(float x) {
    const float x2 = x * x;
    const float t = x * (-2.302208198f + -0.1029432397f * x2);
    return x * __builtin_amdgcn_rcpf(1.0f + __builtin_amdgcn_exp2f(t));
}
__device__ __forceinline__ float dpp_ror1(float x) { return __builtin_bit_cast(float, __builtin_amdgcn_update_dpp(0, __builtin_bit_cast(int, x), 0x121, 0xf, 0xf, false)); }
__device__ __forceinline__ float dpp_rol1(float x) { return __builtin_bit_cast(float, __builtin_amdgcn_update_dpp(0, __builtin_bit_cast(int, x), 0x12F, 0xf, 0xf, false)); }

namespace pg8 {
constexpr int BM = 256, BK = 64, HALF = 128, HTB = HALF * BK * 2, STAGE_BYTES = 8 * HTB, NXCD = 8, WGM = 8;
__device__ __forceinline__ int lds_byte(int r, int c) { const int st = (r >> 4) * 2 + (c >> 5), rr = r & 15, cc = c & 31, ob = rr * 64 + cc * 2; return st * 1024 + (ob ^ (((ob >> 9) & 1) << 5)); }
__device__ __forceinline__ void stage_rc(int b, int& R, int& C) { const int st = b / 1024, sb = b % 1024, swz = sb ^ (((sb >> 9) & 1) << 5); R = (st >> 1) * 16 + swz / 64; C = (st & 1) * 32 + (swz % 64) / 2; }
__device__ __forceinline__ int perm32(int rho) { const int n = rho >> 4, i = rho & 15; return 8 * (i >> 2) + 4 * n + (i & 3); }
struct Unit { int row0, pn; };
struct Gemm { const bf16_t* A; const bf16_t* Bt; int K; };
struct PartOrder {
    int rowbase, rows_per_tile, nMp, nN, nb, rank;
    __device__ bool next(int i, Unit& u) const {
        const int L = i * nb + rank; if (L >= nMp * nN) return false;
        const int nig = WGM * nN, gid = L / nig, fm = gid * WGM, gsz = (nMp - fm) < WGM ? (nMp - fm) : WGM, idx = L % nig;
        u.row0 = rowbase + (fm + idx % gsz) * rows_per_tile; u.pn = idx / gsz; return true;
    }
};

template <class Epi, bool HALO>
__device__ __forceinline__ void gemm_phase(LAS unsigned char* lds, const Gemm g, const PartOrder& S, const Epi& E) {
    int tid_ = threadIdx.x; asm volatile("" : "+v"(tid_));
    const int tid = tid_, wid = __builtin_amdgcn_readfirstlane(tid >> 6), lane = tid & 63, wr = wid >> 2, wc = wid & 3, fr = lane & 15, fq = lane >> 4;
    const int K = g.K, nt = K / BK;
    unsigned voffA[2], voffB[2];
#pragma unroll
    for (int i = 0; i < 2; ++i) { int R, C; stage_rc(tid * 16 + i * 8192, R, C); const int Rb = (R & ~31) + perm32(R & 31); const int Ra = HALO ? (62 * (R >> 6) + 4 * (R & 15) + ((R >> 4) & 3)) : R;
        voffA[i] = (unsigned)(Ra * K + C) * 2u; voffB[i] = (unsigned)(Rb * K + C) * 2u; }
    const size_t kstep = (size_t)(BK * 2);
    const size_t hstepB = (size_t)HALF * K * 2;
    const size_t hstepA = (size_t)(HALO ? 124 : 128) * K * 2;
    const unsigned ldsw = (unsigned)wid * 1024u;
    const int aoff = lds_byte(wr * 64 + fr, fq * 8), boff = lds_byte(wc * 32 + fr, fq * 8);
#define PG8_SA(b, h) (((b) * 2 + (h)) * HTB)
#define PG8_SB(b, h) ((4 + (b) * 2 + (h)) * HTB)
#define PG8_STAGE(bufoff, gbase, voff) do { _Pragma("unroll") for (int _i = 0; _i < 2; ++_i) \
        __builtin_amdgcn_global_load_lds((const unsigned*)((const char*)(gbase) + (voff)[_i]), (LAS unsigned*)(lds + (bufoff) + ldsw + _i * 8192), 16, 0, 0); } while (0)
#define PG8_LDA(dst, b, h) do { _Pragma("unroll") for (int m = 0; m < 4; ++m) _Pragma("unroll") for (int k = 0; k < 2; ++k) dst[m][k] = *(const LAS bf16x8*)(lds + PG8_SA(b, h) + aoff + m * 2048 + k * 1024); } while (0)
#define PG8_LDB(dst, b, h) do { _Pragma("unroll") for (int n = 0; n < 2; ++n) _Pragma("unroll") for (int k = 0; k < 2; ++k) dst[n][k] = *(const LAS bf16x8*)(lds + PG8_SB(b, h) + boff + n * 2048 + k * 1024); } while (0)
#define PG8_MMA(ai, bj, At, Bt) do { __builtin_amdgcn_s_setprio(1); _Pragma("unroll") for (int m = 0; m < 4; ++m) _Pragma("unroll") for (int n = 0; n < 2; ++n) _Pragma("unroll") for (int k = 0; k < 2; ++k) \
        acc[ai][bj][m][n] = __builtin_amdgcn_mfma_f32_16x16x32_bf16(Bt[n][k], At[m][k], acc[ai][bj][m][n], 0, 0, 0); __builtin_amdgcn_s_setprio(0); } while (0)
#define PG8_WAIT_V(n) asm volatile("s_waitcnt vmcnt(" #n ")" ::: "memory")
#define PG8_WAIT_L(n) asm volatile("s_waitcnt lgkmcnt(" #n ")" ::: "memory")
#define PG8_BAR __builtin_amdgcn_s_barrier()
#define PG8_SCHED __builtin_amdgcn_sched_barrier(0)
    Unit cur, nxt; int ui = 0;
    if (!S.next(0, cur)) return;
    f32x4 acc[2][2][4][2];
#pragma unroll
    for (int a = 0; a < 2; ++a)
#pragma unroll
        for (int b = 0; b < 2; ++b)
#pragma unroll
            for (int m = 0; m < 4; ++m)
#pragma unroll
                for (int n = 0; n < 2; ++n) acc[a][b][m][n] = (f32x4){0.f, 0.f, 0.f, 0.f};
    bf16x8 At[4][2], B0[2][2], B1[2][2];
    const char* cA = (const char*)g.A + (long)(cur.row0 - (HALO ? 1 : 0)) * (long)K * 2; const char* cB = (const char*)g.Bt + (size_t)cur.pn * 2 * hstepB;
    PG8_STAGE(PG8_SB(0, 0), cB, voffB); PG8_STAGE(PG8_SB(0, 1), cB + hstepB, voffB); PG8_STAGE(PG8_SA(0, 0), cA, voffA); PG8_STAGE(PG8_SA(0, 1), cA + hstepA, voffA);
    if (wr == 1) PG8_BAR;
    PG8_WAIT_V(2); PG8_BAR;
    PG8_STAGE(PG8_SB(1, 0), cB + kstep, voffB); PG8_STAGE(PG8_SA(1, 0), cA + kstep, voffA); PG8_STAGE(PG8_SB(1, 1), cB + hstepB + kstep, voffB);
    PG8_WAIT_V(6); PG8_BAR;
    for (;;) {
        const bool has_next = S.next(ui + 1, nxt);
        const char* nA = has_next ? (const char*)g.A + (long)(nxt.row0 - (HALO ? 1 : 0)) * (long)K * 2 : cA; const char* nB = has_next ? (const char*)g.Bt + (size_t)nxt.pn * 2 * hstepB : cB;
        for (int t = 0; t < nt; t += 2) {
            const bool last = (t == nt - 2);
            const char* a1 = cA + (size_t)(t + 1) * kstep;
            const char* a2 = last ? nA : cA + (size_t)(t + 2) * kstep; const char* b2 = last ? nB : cB + (size_t)(t + 2) * kstep;
            const char* a3 = a2 + kstep; const char* b3 = b2 + kstep;
            PG8_LDB(B0, 0, 0); PG8_LDB(B1, 0, 1); PG8_SCHED; PG8_LDA(At, 0, 0); PG8_STAGE(PG8_SA(1, 1), a1 + hstepA, voffA);
            PG8_WAIT_V(8); PG8_WAIT_L(0); PG8_BAR; PG8_MMA(0, 0, At, B0); PG8_MMA(0, 1, At, B1); PG8_BAR; PG8_SCHED;
            PG8_LDA(At, 0, 1); PG8_STAGE(PG8_SB(0, 0), b2, voffB); PG8_STAGE(PG8_SB(0, 1), b2 + hstepB, voffB); PG8_STAGE(PG8_SA(0, 0), a2, voffA);
            PG8_WAIT_V(8); PG8_WAIT_L(0); PG8_BAR; PG8_MMA(1, 0, At, B0); PG8_MMA(1, 1, At, B1); PG8_BAR; PG8_SCHED;
            PG8_LDB(B0, 1, 0); PG8_LDB(B1, 1, 1); PG8_SCHED; PG8_LDA(At, 1, 0); PG8_STAGE(PG8_SA(0, 1), a2 + hstepA, voffA);
            PG8_WAIT_V(8); PG8_WAIT_L(0); PG8_BAR; PG8_MMA(0, 0, At, B0); PG8_MMA(0, 1, At, B1); PG8_BAR; PG8_SCHED;
            PG8_LDA(At, 1, 1); PG8_STAGE(PG8_SB(1, 0), b3, voffB); PG8_STAGE(PG8_SB(1, 1), b3 + hstepB, voffB); PG8_STAGE(PG8_SA(1, 0), a3, voffA);
            PG8_WAIT_V(8); PG8_WAIT_L(0); PG8_BAR; PG8_MMA(1, 0, At, B0); PG8_MMA(1, 1, At, B1); PG8_BAR; PG8_SCHED;
        }
        if (wr == 0) PG8_BAR;
        E(acc, cur, wr, wc, fr, fq);
        if (!has_next) break;
#pragma unroll
        for (int a = 0; a < 2; ++a)
#pragma unroll
            for (int b = 0; b < 2; ++b)
#pragma unroll
                for (int m = 0; m < 4; ++m)
#pragma unroll
                    for (int n = 0; n < 2; ++n) acc[a][b][m][n] = (f32x4){0.f, 0.f, 0.f, 0.f};
        cur = nxt; cA = nA; cB = nB; ++ui;
        if (wr == 1) PG8_BAR;
    }
    PG8_WAIT_V(0);
    PG8_BAR;
#undef PG8_SA
#undef PG8_SB
#undef PG8_STAGE
#undef PG8_LDA
#undef PG8_LDB
#undef PG8_MMA
#undef PG8_WAIT_V
#undef PG8_WAIT_L
#undef PG8_BAR
#undef PG8_SCHED
}
}

struct EpiZ {
    bf16_t* Y; bf16_t* U; bf16_t* V;
    __device__ __forceinline__ void operator()(const f32x4 (&acc)[2][2][4][2], const pg8::Unit& u, int wr, int wc, int fr, int fq) const {
        const int row0 = u.row0 + wr * 64 + fr;
        bf16_t* base; int ld, colt; bool act;
        if (u.pn < 2) { base = Y; ld = 512; colt = u.pn * 256; act = false; }
        else if (u.pn < 4) { base = U; ld = 512; colt = (u.pn - 2) * 256; act = true; }
        else { base = V; ld = 512; colt = (u.pn - 4) * 256; act = true; }
        const int col0 = colt + wc * 32 + 8 * fq;
#pragma unroll
        for (int ai = 0; ai < 2; ++ai)
#pragma unroll
            for (int m = 0; m < 4; ++m) { bf16_t* rowp = base + (size_t)(row0 + ai * 128 + m * 16) * ld + col0;
#pragma unroll
                for (int bj = 0; bj < 2; ++bj) { f32x4 v0 = acc[ai][bj][m][0], v1 = acc[ai][bj][m][1];
                    if (act) {
#pragma unroll
                        for (int e = 0; e < 4; ++e) { v0[e] = gelu_f(v0[e]); v1[e] = gelu_f(v1[e]); } }
                    u32x4 w; w.x = cvt_pk_bf16(v0[0], v0[1]); w.y = cvt_pk_bf16(v0[2], v0[3]); w.z = cvt_pk_bf16(v1[0], v1[1]); w.w = cvt_pk_bf16(v1[2], v1[3]);
                    *(u32x4*)(rowp + bj * 128) = w; } }
    }
};
struct EpiMS {
    bf16_t* O; float* SSQ;
    __device__ __forceinline__ void operator()(const f32x4 (&acc)[2][2][4][2], const pg8::Unit& u, int wr, int wc, int fr, int fq) const {
        const int row0 = u.row0 + wr * 64 + fr; const int col0 = u.pn * 256 + wc * 32 + 8 * fq;
#pragma unroll
        for (int ai = 0; ai < 2; ++ai)
#pragma unroll
            for (int m = 0; m < 4; ++m) { const int row = row0 + ai * 128 + m * 16; bf16_t* rowp = O + (size_t)row * 1024 + col0; float s = 0.f;
#pragma unroll
                for (int bj = 0; bj < 2; ++bj) { const f32x4 v0 = acc[ai][bj][m][0], v1 = acc[ai][bj][m][1];
                    s += (v0[0] * v0[0] + v0[1] * v0[1]) + (v0[2] * v0[2] + v0[3] * v0[3]) + (v1[0] * v1[0] + v1[1] * v1[1]) + (v1[2] * v1[2] + v1[3] * v1[3]);
                    u32x4 w; w.x = cvt_pk_bf16(v0[0], v0[1]); w.y = cvt_pk_bf16(v0[2], v0[3]); w.z = cvt_pk_bf16(v1[0], v1[1]); w.w = cvt_pk_bf16(v1[2], v1[3]);
                    *(u32x4*)(rowp + bj * 128) = w; }
                s += __shfl_xor(s, 16); s += __shfl_xor(s, 32);
                if (fq == 0) SSQ[(size_t)row * 16 + u.pn * 4 + wc] = s; }
    }
};
__device__ __forceinline__ void panel_wait(unsigned* cnt, int wid, int lane) {
    asm volatile("s_waitcnt vmcnt(0)" ::: "memory");
    if (lane == 0) __hip_atomic_fetch_add(cnt, 1u, __ATOMIC_RELAXED, __HIP_MEMORY_SCOPE_AGENT);
    if (wid == 0) {
        unsigned spins = 0;
        while ((unsigned)__builtin_amdgcn_readfirstlane(__hip_atomic_load(cnt, __ATOMIC_RELAXED, __HIP_MEMORY_SCOPE_AGENT)) < 32u) { if (++spins > (1u << 22)) break; __builtin_amdgcn_s_sleep(1); }
        __builtin_amdgcn_fence(__ATOMIC_ACQUIRE, "agent");
        asm volatile("s_waitcnt vmcnt(0)" ::: "memory");
    }
    asm volatile("" ::: "memory"); __builtin_amdgcn_s_barrier(); asm volatile("" ::: "memory");
}
__device__ __forceinline__ float sum16(const float* p) {
    const f32x4 s0 = *(const f32x4*)p, s1 = *(const f32x4*)(p + 4), s2 = *(const f32x4*)(p + 8), s3 = *(const f32x4*)(p + 12);
    return ((s0[0] + s0[1]) + (s0[2] + s0[3])) + ((s1[0] + s1[1]) + (s1[2] + s1[3])) + ((s2[0] + s2[1]) + (s2[2] + s2[3])) + ((s3[0] + s3[1]) + (s3[2] + s3[3]));
}
struct EpiY {
    float* out; const bf16_t* H2; const float* IRS; float* SSQ; unsigned* cnt; const float* g3;
    __device__ __forceinline__ void operator()(f32x4 (&acc)[2][2][4][2], const pg8::Unit& u, int wr, int wc, int fr, int fq) const {
        const int row0 = u.row0 + wr * 64 + fr; const int col0 = u.pn * 256 + wc * 32 + 8 * fq;
        const int wid = wr * 4 + wc, lane = fq * 16 + fr;
#pragma unroll
        for (int ai = 0; ai < 2; ++ai)
#pragma unroll
            for (int m = 0; m < 4; ++m) { const int row = row0 + ai * 128 + m * 16; float s = 0.f;
#pragma unroll
                for (int bj = 0; bj < 2; ++bj) { const f32x4 v0 = acc[ai][bj][m][0], v1 = acc[ai][bj][m][1];
                    s += (v0[0] * v0[0] + v0[1] * v0[1]) + (v0[2] * v0[2] + v0[3] * v0[3]) + (v1[0] * v1[0] + v1[1] * v1[1]) + (v1[2] * v1[2] + v1[3] * v1[3]); }
                s += __shfl_xor(s, 16); s += __shfl_xor(s, 32);
                if (fq == 0) __hip_atomic_store(SSQ + (size_t)row * 16 + u.pn * 4 + wc, s, __ATOMIC_RELAXED, __HIP_MEMORY_SCOPE_AGENT); }
        panel_wait(cnt + (u.row0 >> 8), wid, lane);
        f32x4 gv[2][2];
#pragma unroll
        for (int bj = 0; bj < 2; ++bj) { gv[bj][0] = *(const f32x4*)(g3 + col0 + bj * 128); gv[bj][1] = *(const f32x4*)(g3 + col0 + bj * 128 + 4); }
        float rscv[8], irsv[8];
#pragma unroll
        for (int k = 0; k < 8; ++k) { const int row = row0 + (k >> 2) * 128 + (k & 3) * 16; rscv[k] = sum16(SSQ + (size_t)row * 16); irsv[k] = IRS[(size_t)row * 16]; }
#pragma unroll
        for (int k = 0; k < 8; ++k) rscv[k] = rsqrtf(rscv[k] * (1.0f / 1024.0f) + EPS);
#pragma unroll
        for (int ai = 0; ai < 2; ++ai)
#pragma unroll
            for (int m = 0; m < 4; ++m) { const int row = row0 + ai * 128 + m * 16;
                const float rsc = rscv[ai * 4 + m]; const float irs = irsv[ai * 4 + m];
#pragma unroll
                for (int bj = 0; bj < 2; ++bj) { const u32x4 hw = *(const u32x4*)(H2 + (size_t)row * DM + col0 + bj * 128);
                    const f32x4 c0 = acc[ai][bj][m][0], c1 = acc[ai][bj][m][1]; f32x4 y0, y1;
                    y0[0] = bf_lo(hw.x) * irs + c0[0] * rsc * gv[bj][0][0]; y0[1] = bf_hi(hw.x) * irs + c0[1] * rsc * gv[bj][0][1];
                    y0[2] = bf_lo(hw.y) * irs + c0[2] * rsc * gv[bj][0][2]; y0[3] = bf_hi(hw.y) * irs + c0[3] * rsc * gv[bj][0][3];
                    y1[0] = bf_lo(hw.z) * irs + c1[0] * rsc * gv[bj][1][0]; y1[1] = bf_hi(hw.z) * irs + c1[1] * rsc * gv[bj][1][1];
                    y1[2] = bf_lo(hw.w) * irs + c1[2] * rsc * gv[bj][1][2]; y1[3] = bf_hi(hw.w) * irs + c1[3] * rsc * gv[bj][1][3];
                    float* op = out + (size_t)row * DM + col0 + bj * 128; *(f32x4*)op = y0; *(f32x4*)(op + 4) = y1; }
                if (m & 1) asm volatile("" ::: "memory"); }
    }
};
__device__ __forceinline__ float dpp_shr1(float x) { return __builtin_bit_cast(float, __builtin_amdgcn_update_dpp(0, __builtin_bit_cast(int, x), 0x111, 0xf, 0xf, true)); }
__device__ __forceinline__ float dpp_shl1(float x) { return __builtin_bit_cast(float, __builtin_amdgcn_update_dpp(0, __builtin_bit_cast(int, x), 0x101, 0xf, 0xf, true)); }
__device__ __forceinline__ f32x2 gelu2(f32x2 x) {
    const f32x2 x2 = x * x;
    const f32x2 t = x * (x2 * -0.1029432397f + -2.302208198f);
    f32x2 d; d.x = __builtin_amdgcn_exp2f(t.x); d.y = __builtin_amdgcn_exp2f(t.y);
    d = d + 1.0f;
    f32x2 rc; rc.x = __builtin_amdgcn_rcpf(d.x); rc.y = __builtin_amdgcn_rcpf(d.y);
    return x * rc;
}
__device__ __forceinline__ void ffn_conv(f32x4 (&acc)[2][2][4][2], const float* cw, const float* cb, int cg0, unsigned firstm, unsigned lastm, const bool MASK) {
    f32x2 Wc[8], Wn[8];
#define FFN_LOADW(W, idx) do { const int cge_ = cg0 + 4 * ((idx) >> 1) + 2 * ((idx) & 1); \
        W[0] = *(const f32x2*)(cw + cge_); W[1] = *(const f32x2*)(cw + N3 + cge_); W[2] = *(const f32x2*)(cw + 2 * N3 + cge_); W[3] = *(const f32x2*)(cb + cge_); \
        W[4] = *(const f32x2*)(cw + DFF + cge_); W[5] = *(const f32x2*)(cw + N3 + DFF + cge_); W[6] = *(const f32x2*)(cw + 2 * N3 + DFF + cge_); W[7] = *(const f32x2*)(cb + DFF + cge_); } while (0)
    FFN_LOADW(Wc, 0);
#pragma unroll
    for (int idx = 0; idx < 4; ++idx) {
        const int n = idx >> 1, ep = idx & 1;
        if (idx < 3) FFN_LOADW(Wn, idx + 1);
        const f32x2 W0g = Wc[0], W1g = Wc[1], W2g = Wc[2], Bg = Wc[3], W0u = Wc[4], W1u = Wc[5], W2u = Wc[6], Bu = Wc[7];
#pragma unroll
        for (int ai = 0; ai < 2; ++ai) {
            f32x2 g[4], u[4], r[4];
#pragma unroll
            for (int m = 0; m < 4; ++m) { g[m] = ep ? acc[ai][0][m][n].hi : acc[ai][0][m][n].lo; u[m] = ep ? acc[ai][1][m][n].hi : acc[ai][1][m][n].lo; }
            f32x2 gup0, gdn3, uup0, udn3;
            gup0.x = dpp_shr1(g[3].x); gup0.y = dpp_shr1(g[3].y); gdn3.x = dpp_shl1(g[0].x); gdn3.y = dpp_shl1(g[0].y);
            uup0.x = dpp_shr1(u[3].x); uup0.y = dpp_shr1(u[3].y); udn3.x = dpp_shl1(u[0].x); udn3.y = dpp_shl1(u[0].y);
#pragma unroll
            for (int m = 0; m < 4; ++m) { const int bit = ai * 4 + m;
                f32x2 gu = m ? g[m > 0 ? m - 1 : 0] : gup0, gd = m < 3 ? g[m < 3 ? m + 1 : 3] : gdn3;
                f32x2 uu = m ? u[m > 0 ? m - 1 : 0] : uup0, ud = m < 3 ? u[m < 3 ? m + 1 : 3] : udn3;
                if (MASK) { if ((firstm >> bit) & 1u) { gu = (f32x2){0.f, 0.f}; uu = (f32x2){0.f, 0.f}; }
                            if ((lastm >> bit) & 1u) { gd = (f32x2){0.f, 0.f}; ud = (f32x2){0.f, 0.f}; } }
                const f32x2 gv = Bg + W0g * gu + W1g * g[m] + W2g * gd;
                const f32x2 uv = Bu + W0u * uu + W1u * u[m] + W2u * ud;
                r[m] = gelu2(gv) * uv; }
            asm volatile("" : "+v"(r[0]), "+v"(r[1]), "+v"(r[2]), "+v"(r[3]));
#pragma unroll
            for (int m = 0; m < 4; ++m) { if (ep) acc[ai][0][m][n].hi = r[m]; else acc[ai][0][m][n].lo = r[m]; }
        }
#pragma unroll
        for (int k = 0; k < 8; ++k) Wc[k] = Wn[k];
    }
#undef FFN_LOADW
}
struct EpiFFN {
    bf16_t* HID; const float* cw; const float* cb; int rowend;
    __device__ __forceinline__ void operator()(f32x4 (&acc)[2][2][4][2], const pg8::Unit& u, int wr, int wc, int fr, int fq) const {
        const int cg0 = u.pn * 128 + wc * 32 + 8 * fq;
        unsigned firstm = 0, lastm = 0, validm = 0;
#pragma unroll
        for (int ai = 0; ai < 2; ++ai)
#pragma unroll
            for (int m = 0; m < 4; ++m) { const int i = 4 * fr + m; const int ga = u.row0 + 62 * (2 * ai + wr) - 1 + i; const int bit = ai * 4 + m;
                const bool first = (ga == 0) || (ga >= 16384 && (ga & 8191) == 0);
                const bool last = ((ga + 1) >= 16384 && ((ga + 1) & 8191) == 0);
                const bool valid = (i >= 1) && (i <= 62) && (ga < rowend);
                firstm |= (first ? 1u : 0u) << bit; lastm |= (last ? 1u : 0u) << bit; validm |= (valid ? 1u : 0u) << bit; }
        const bool hasb = __builtin_amdgcn_ballot_w64((firstm | lastm) != 0u) != 0ull;
        ffn_conv(acc, cw, cb, cg0, firstm, lastm, hasb);
#pragma unroll
        for (int ai = 0; ai < 2; ++ai)
#pragma unroll
            for (int m = 0; m < 4; ++m) { const int bit = ai * 4 + m; const int ga = u.row0 + 62 * (2 * ai + wr) - 1 + 4 * fr + m;
                if ((validm >> bit) & 1u) { const f32x4 v0 = acc[ai][0][m][0], v1 = acc[ai][0][m][1];
                    u32x4 w; w.x = cvt_pk_bf16(v0[0], v0[1]); w.y = cvt_pk_bf16(v0[2], v0[3]); w.z = cvt_pk_bf16(v1[0], v1[1]); w.w = cvt_pk_bf16(v1[2], v1[3]);
                    *(u32x4*)(HID + (size_t)ga * DFF + cg0) = w; } }
    }
};

template <int MT, int KS>
__device__ __forceinline__ void mix_load_w(bf16x8 (&wf)[KS][MT], const bf16_t* W, int ldw, const int (&mrow)[MT], int lane) {
    const int fr = lane & 15, g = lane >> 4;
#pragma unroll
    for (int ks = 0; ks < KS; ++ks)
#pragma unroll
        for (int i = 0; i < MT; ++i) wf[ks][i] = *(const bf16x8*)(W + (size_t)(mrow[i] + fr) * ldw + ks * 32 + 8 * g);
}
template <int MT, int KS>
__device__ __forceinline__ void mix_mma(f32x4 (&acc)[MT][8], const bf16x8 (&wf)[KS][MT], LAS const unsigned char* xt, int pitch, int ncol0, int lane) {
    const int fr = lane & 15, g = lane >> 4, q = fr >> 2, p = fr & 3;
    const int base = (8 * g + q) * pitch + (ncol0 + 4 * p) * 2;
#pragma unroll
    for (int ks = 0; ks < KS; ++ks) {
        bf16x8 xf[8];
#pragma unroll
        for (int nt = 0; nt < 8; ++nt) {
            const int a0 = base + ks * 32 * pitch + nt * 32;
            const bf16x4 lo = __builtin_amdgcn_ds_read_tr16_b64_v4i16((LAS bf16x4*)(xt + a0));
            const bf16x4 hi = __builtin_amdgcn_ds_read_tr16_b64_v4i16((LAS bf16x4*)(xt + a0 + 4 * pitch));
            xf[nt] = __builtin_shufflevector(lo, hi, 0, 1, 2, 3, 4, 5, 6, 7);
        }
#pragma unroll
        for (int nt = 0; nt < 8; ++nt)
#pragma unroll
            for (int i = 0; i < MT; ++i) acc[i][nt] = __builtin_amdgcn_mfma_f32_16x16x32_bf16(xf[nt], wf[ks][i], acc[i][nt], 0, 0, 0);
    }
}

struct Params {
    const float* x_prompt; const float* x_sample; const float* pre_mix_norm; const float* w_in; const float* sgu_norm; const float* w_spatial; const float* b_spatial;
    const float* w_out; const float* post_mix_norm; const float* pre_ffn_norm; const float* w_up; const float* conv_w; const float* conv_b; const float* w_down; const float* post_ffn_norm;
    float* out; unsigned char* ws; int never; int census; int ph_lo; int ph_hi; int ck; int pad_;
};

struct Part { int r0, r1, nb, rank, px, nx; };
__device__ __forceinline__ const float* xrow(const Params& p, int r) { return r < 16384 ? p.x_prompt + (size_t)r * DM : p.x_sample + (size_t)(r - 16384) * DM; }

__device__ void p0_prep(const Params& P, LAS unsigned char* lds, int G, const Part pt) {
    const int tid = threadIdx.x, lane = tid & 63, wave = tid >> 6;
    unsigned char* ws = P.ws;
    LAS float* ctab = (LAS float*)lds;
    if (tid < 128) ctab[tid] = cospif((float)tid * (1.0f / 64.0f));
    __syncthreads();
    const long gt = (long)blockIdx.x * NTHR + tid, GT = (long)G * NTHR;
    {
        bf16_t* W1T = (bf16_t*)(ws + WS_W1T);
        for (long it = gt; it < 128L * 1536; it += GT) {
            const int n = (int)(it % 1536), k0 = (int)(it / 1536) * 8;
            float a[8];
#pragma unroll
            for (int i = 0; i < 8; ++i) a[i] = P.w_in[(size_t)(k0 + i) * 1536 + n] * P.pre_mix_norm[k0 + i];
            u32x4 w; w.x = cvt_pk_bf16(a[0], a[1]); w.y = cvt_pk_bf16(a[2], a[3]); w.z = cvt_pk_bf16(a[4], a[5]); w.w = cvt_pk_bf16(a[6], a[7]);
            *(u32x4*)(W1T + (size_t)n * 1024 + k0) = w;
        }
        { bf16_t* WC = (bf16_t*)(ws + WS_WC);
          for (long it = gt; it < 32768; it += GT) { const int lp = (int)(it >> 7), c = (int)(it & 127), l = lp & 127, im = lp >> 7;
              WC[it] = (bf16_t)(cvt_pk_bf16(ctab[(l * c + 32 * im) & 127] * 0.08838834764831845f, 0.f) & 0xffffu); } }
    }
    {
        bf16_t* W2T = (bf16_t*)(ws + WS_W2T);
        for (long it = gt; it < 128L * 1024; it += GT) {
            const int n = (int)(it & 1023), k0 = (int)(it >> 10) * 8;
            float a[8];
#pragma unroll
            for (int i = 0; i < 8; ++i) a[i] = P.w_out[(size_t)(k0 + i) * 1024 + n];
            u32x4 w; w.x = cvt_pk_bf16(a[0], a[1]); w.y = cvt_pk_bf16(a[2], a[3]); w.z = cvt_pk_bf16(a[4], a[5]); w.w = cvt_pk_bf16(a[6], a[7]);
            *(u32x4*)(W2T + (size_t)n * 1024 + k0) = w;
        }
    }
    {
        bf16_t* W3T = (bf16_t*)(ws + WS_W3T);
        for (long it = gt; it < 128L * N3; it += GT) {
            const int np = (int)(it % N3), k0 = (int)(it / N3) * 8;
            const int pn = np >> 8, half = (np >> 7) & 1, j = np & 127, col = half * DFF + 128 * pn + j;
            float a[8];
#pragma unroll
            for (int i = 0; i < 8; ++i) a[i] = P.w_up[(size_t)(k0 + i) * N3 + col] * P.pre_ffn_norm[k0 + i];
            u32x4 w; w.x = cvt_pk_bf16(a[0], a[1]); w.y = cvt_pk_bf16(a[2], a[3]); w.z = cvt_pk_bf16(a[4], a[5]); w.w = cvt_pk_bf16(a[6], a[7]);
            *(u32x4*)(W3T + (size_t)np * 1024 + k0) = w;
        }
    }
    {
        bf16_t* W4T = (bf16_t*)(ws + WS_W4T);
        for (long it = gt; it < 352L * 1024; it += GT) {
            const int n = (int)(it & 1023), k0 = (int)(it >> 10) * 8;
            float a[8];
#pragma unroll
            for (int i = 0; i < 8; ++i) a[i] = P.w_down[(size_t)(k0 + i) * 1024 + n];
            u32x4 w; w.x = cvt_pk_bf16(a[0], a[1]); w.y = cvt_pk_bf16(a[2], a[3]); w.z = cvt_pk_bf16(a[4], a[5]); w.w = cvt_pk_bf16(a[6], a[7]);
            *(u32x4*)(W4T + (size_t)n * DFF + k0) = w;
        }
    }
    {
        bf16_t* WSP = (bf16_t*)(ws + WS_WSP); bf16_t* WA128 = (bf16_t*)(ws + WS_WA128); bf16_t* WA64 = (bf16_t*)(ws + WS_WA64); bf16_t* WB = (bf16_t*)(ws + WS_WB);
        f32x2* TW = (f32x2*)(ws + WS_TW);
        for (long it = gt; it < 65536; it += GT) {
            { const float v = P.w_spatial[it]; WSP[it] = (bf16_t)(cvt_pk_bf16(v, 0.f) & 0xffffu); }
            { const int m = (int)(it >> 8), k = (int)(it & 255); const int ka = m & 127, im = m >> 7, a = k & 127, kin = k >> 7;
              float s, c; sincospif((float)((ka * a) & 127) * (1.0f / 64.0f), &s, &c);
              const float v = (im == 0) ? (kin == 0 ? c : s) : (kin == 0 ? -s : c);
              WA128[it] = (bf16_t)(cvt_pk_bf16(v * 0.08838834764831845f, 0.f) & 0xffffu); }
            if (it < 16384) { const int m = (int)(it >> 7), k = (int)(it & 127); const int ka = m & 63, im = m >> 6, a = k & 63, kin = k >> 6;
              float s, c; sincospif((float)((ka * a) & 63) * (1.0f / 32.0f), &s, &c);
              const float v = (im == 0) ? (kin == 0 ? c : s) : (kin == 0 ? -s : c);
              WA64[it] = (bf16_t)(cvt_pk_bf16(v * 0.125f, 0.f) & 0xffffu); }
            if (it < 32768) { const int kb = (int)(it >> 8), k = (int)(it & 255); const int b = k & 127, kin = k >> 7;
              float s, c; sincospif((float)((kb * b) & 127) * (1.0f / 64.0f), &s, &c);
              const float v = (kin == 0) ? c : s;
              WB[it] = (bf16_t)(cvt_pk_bf16(v * 0.08838834764831845f, 0.f) & 0xffffu); }
            if (it < 16384) { float s, c; sincospif((float)it * (1.0f / 8192.0f), &s, &c); TW[it] = (f32x2){c, s}; }
        }
    }
    {
        bf16_t* H0 = (bf16_t*)(ws + WS_H0);
        for (int r = pt.r0 + pt.rank * 8 + wave; r < pt.r1; r += pt.nb * 8) {
            const float* xp = xrow(P, r);
            f32x4 v[4]; float s = 0.f;
#pragma unroll
            for (int i = 0; i < 4; ++i) { v[i] = *(const f32x4*)(xp + i * 256 + lane * 4); s += (v[i][0] * v[i][0] + v[i][1] * v[i][1]) + (v[i][2] * v[i][2] + v[i][3] * v[i][3]); }
#pragma unroll
            for (int o = 1; o < 64; o <<= 1) s += __shfl_xor(s, o);
            const float rs = rsqrtf(s * (1.0f / 1024.0f) + EPS);
            if (lane == 0) ((float*)(ws + WS_SSQC))[(size_t)r * 16] = 1.0f / rs;
#pragma unroll
            for (int i = 0; i < 4; ++i) { u32x2 w; w.x = cvt_pk_bf16(v[i][0] * rs, v[i][1] * rs); w.y = cvt_pk_bf16(v[i][2] * rs, v[i][3] * rs);
                *(u32x2*)(H0 + (size_t)r * DM + i * 256 + lane * 4) = w; }
        }
    }
    __syncthreads();
}

template <bool SAMPLE>
__device__ __forceinline__ void chan_stage(const bf16x8 (&wcr)[2][4], LAS const unsigned char* zt, LAS unsigned char* xt, int w, int fr, int g4) {
#pragma unroll
    for (int q = 0; q < 4; ++q) {
        bf16x8 zf[2][4];
#pragma unroll
        for (int h = 0; h < 2; ++h)
#pragma unroll
            for (int ks = 0; ks < 4; ++ks) zf[h][ks] = *(const LAS bf16x8*)(zt + (16 * (2 * q + h) + fr) * 272 + 64 * ks + 16 * g4);
        f32x4 c[2][2];
#pragma unroll
        for (int h = 0; h < 2; ++h)
#pragma unroll
            for (int t = 0; t < 2; ++t) { c[h][t] = (f32x4){0.f, 0.f, 0.f, 0.f};
#pragma unroll
                for (int ks = 0; ks < 4; ++ks) c[h][t] = __builtin_amdgcn_mfma_f32_16x16x32_bf16(wcr[t][ks], zf[h][ks], c[h][t], 0, 0, 0); }
#pragma unroll
        for (int h = 0; h < 2; ++h)
#pragma unroll
            for (int t = 0; t < 2; ++t) { const int za = 16 * (2 * q + h) + fr, lp = 32 * w + 16 * t + 4 * g4, kin = lp >> 7, l = lp & 127;
                u32x2 o; o.x = cvt_pk_bf16(c[h][t][0], c[h][t][1]); o.y = cvt_pk_bf16(c[h][t][2], c[h][t][3]);
                if (SAMPLE) { const int a = za & 63, bi = za >> 6; *(LAS u32x2*)(xt + (kin * 64 + a) * 544 + (bi * 128 + l) * 2) = o; }
                else *(LAS u32x2*)(xt + (kin * 128 + za) * 288 + l * 2) = o; }
    }
}
__device__ void p2_mix(const Params& P, LAS unsigned char* lds, int G, const Part pt) {
    const int tid = threadIdx.x, lane = tid & 63, w = __builtin_amdgcn_readfirstlane(tid >> 6), fr = lane & 15, g4 = lane >> 4;
    unsigned char* ws = P.ws;
    const bf16_t* YB = (const bf16_t*)P.out; const bf16_t* UB = (const bf16_t*)(ws + WS_U); const bf16_t* VB = (const bf16_t*)(ws + WS_V);
    bf16_t* TB = (bf16_t*)P.out + (size_t)MTOK * DM; bf16_t* CAT = (bf16_t*)(ws + WS_CAT);
    const bf16_t* WA128 = (const bf16_t*)(ws + WS_WA128); const bf16_t* WA64 = (const bf16_t*)(ws + WS_WA64); const bf16_t* WSP = (const bf16_t*)(ws + WS_WSP);
    const f32x2* TW = (const f32x2*)(ws + WS_TW);
    LAS unsigned char* zt = lds + 73728;
    bf16x8 wcr[2][4];
    { const bf16_t* WCg = (const bf16_t*)(ws + WS_WC);
#pragma unroll
      for (int t = 0; t < 2; ++t)
#pragma unroll
          for (int ks = 0; ks < 4; ++ks) wcr[t][ks] = *(const bf16x8*)(WCg + (size_t)(32 * w + 16 * t + fr) * 128 + 32 * ks + 8 * g4); }
    u32x4 zr[4];
#define Z_LOAD(uu) do { int grp_, rb_, sa_; if ((uu) < 512) { grp_ = (uu) & 3; rb_ = (uu) >> 2; sa_ = 0; } else { const int s_ = (uu) - 512, r_ = s_ & 255; grp_ = r_ & 3; rb_ = 16384 + 8192 * (s_ >> 8) + (r_ >> 2) * 2; sa_ = 1; } \
        _Pragma("unroll") for (int i = 0; i < 4; ++i) { const int idx = tid + NTHR * i, ch = idx & 15, za = idx >> 4; const int row_ = sa_ ? rb_ + 128 * (za & 63) + (za >> 6) : 128 * za + rb_; \
            zr[i] = *(const u32x4*)(YB + (size_t)row_ * 512 + 128 * grp_ + ch * 8); } } while (0)
#define Z_STORE() do { _Pragma("unroll") for (int i = 0; i < 4; ++i) { const int idx = tid + NTHR * i, ch = idx & 15, za = idx >> 4; *(LAS u32x4*)(zt + za * 272 + ch * 16) = zr[i]; } } while (0)
    if ((int)blockIdx.x < 2560) { Z_LOAD((int)blockIdx.x); Z_STORE(); }
    for (int u = blockIdx.x; u < 2560; u += G) {
        const bool more = (u + G < 2560);
        __syncthreads();
        if (u < 512) {
            const int grp = u & 3, b = u >> 2;
            const int mrow[2] = {16 * w, 128 + 16 * w};
            bf16x8 wf[8][2]; mix_load_w<2, 8>(wf, WA128, 256, mrow, lane);
            chan_stage<false>(wcr, zt, lds, w, fr, g4);
            __syncthreads();
            if (more) Z_LOAD(u + G);
            f32x4 acc[2][8];
#pragma unroll
            for (int i = 0; i < 2; ++i)
#pragma unroll
                for (int n = 0; n < 8; ++n) acc[i][n] = (f32x4){0.f, 0.f, 0.f, 0.f};
            mix_mma<2, 8>(acc, wf, lds, 288, 0, lane);
            const int ka = 16 * w + fr; const f32x2 tw = TW[ka * b]; const float cs = tw.x, sn = tw.y;
            bf16_t* op = TB + (size_t)(128 * ka + b) * DM + 256 * grp + 4 * g4;
#pragma unroll
            for (int n = 0; n < 8; ++n) { const f32x4 tr = acc[0][n], ti = acc[1][n]; u32x2 wr_, wi_;
                wr_.x = cvt_pk_bf16(cs * tr[0] + sn * ti[0], cs * tr[1] + sn * ti[1]); wr_.y = cvt_pk_bf16(cs * tr[2] + sn * ti[2], cs * tr[3] + sn * ti[3]);
                wi_.x = cvt_pk_bf16(cs * ti[0] - sn * tr[0], cs * ti[1] - sn * tr[1]); wi_.y = cvt_pk_bf16(cs * ti[2] - sn * tr[2], cs * ti[3] - sn * tr[3]);
                *(u32x2*)(op + 16 * n) = wr_; *(u32x2*)(op + 128 + 16 * n) = wi_; }
        } else {
            const int s = u - 512, samp = s >> 8, r = s & 255, grp = r & 3, b0 = (r >> 2) * 2; const int seq0 = 16384 + 8192 * samp;
            const int kblk = w & 3, bi_w = w >> 2;
            const int mrow[2] = {16 * kblk, 64 + 16 * kblk};
            bf16x8 wf[4][2]; mix_load_w<2, 4>(wf, WA64, 128, mrow, lane);
            chan_stage<true>(wcr, zt, lds, w, fr, g4);
            __syncthreads();
            if (more) Z_LOAD(u + G);
            f32x4 acc[2][8];
#pragma unroll
            for (int i = 0; i < 2; ++i)
#pragma unroll
                for (int n = 0; n < 8; ++n) acc[i][n] = (f32x4){0.f, 0.f, 0.f, 0.f};
            mix_mma<2, 4>(acc, wf, lds, 544, 128 * bi_w, lane);
            const int ka = 16 * kblk + fr, b = b0 + bi_w; const f32x2 tw = TW[2 * (ka * b)]; const float cs = tw.x, sn = tw.y;
            bf16_t* op = TB + (size_t)(seq0 + 128 * ka + b) * DM + 256 * grp + 4 * g4;
#pragma unroll
            for (int n = 0; n < 8; ++n) { const f32x4 tr = acc[0][n], ti = acc[1][n]; u32x2 wr_, wi_;
                wr_.x = cvt_pk_bf16(cs * tr[0] + sn * ti[0], cs * tr[1] + sn * ti[1]); wr_.y = cvt_pk_bf16(cs * tr[2] + sn * ti[2], cs * tr[3] + sn * ti[3]);
                wi_.x = cvt_pk_bf16(cs * ti[0] - sn * tr[0], cs * ti[1] - sn * tr[1]); wi_.y = cvt_pk_bf16(cs * ti[2] - sn * tr[2], cs * ti[3] - sn * tr[3]);
                *(u32x2*)(op + 16 * n) = wr_; *(u32x2*)(op + 128 + 16 * n) = wi_; }
        }
        if (more) Z_STORE();
    }
    __syncthreads();
#undef Z_LOAD
#undef Z_STORE
    {
        const int c0 = pt.r0 >> 7, nun = ((pt.r1 - pt.r0) >> 7) * 4;
        u32x4 xr[4];
#define SGU_LOAD(ss) do { const int chunk_ = c0 + ((ss) >> 2), h_ = (ss) & 3; _Pragma("unroll") for (int i = 0; i < 4; ++i) { const int idx = tid + NTHR * i, ch = idx & 15, q = idx >> 4; \
            xr[i] = *(const u32x4*)(VB + (size_t)(chunk_ * 128 + q) * 512 + 128 * h_ + ch * 8); } } while (0)
        if (pt.rank < nun) SGU_LOAD(pt.rank);
        for (int s = pt.rank; s < nun; s += pt.nb) {
            const int chunk = c0 + (s >> 2), h = s & 3;
            const int mrow[1] = {16 * w};
            bf16x8 wf[4][1]; mix_load_w<1, 4>(wf, WSP + h * 16384, 128, mrow, lane);
            { const int ch = tid & 15; const f32x4 g0 = *(const f32x4*)(P.sgu_norm + h * 128 + ch * 8), g1 = *(const f32x4*)(P.sgu_norm + h * 128 + ch * 8 + 4);
#pragma unroll
              for (int i = 0; i < 4; ++i) { const int idx = tid + NTHR * i, q = idx >> 4;
                float v[8]; v[0] = bf_lo(xr[i].x); v[1] = bf_hi(xr[i].x); v[2] = bf_lo(xr[i].y); v[3] = bf_hi(xr[i].y); v[4] = bf_lo(xr[i].z); v[5] = bf_hi(xr[i].z); v[6] = bf_lo(xr[i].w); v[7] = bf_hi(xr[i].w);
                float ss = 0.f;
#pragma unroll
                for (int j = 0; j < 8; ++j) ss += v[j] * v[j];
                ss += __shfl_xor(ss, 1); ss += __shfl_xor(ss, 2); ss += __shfl_xor(ss, 4); ss += __shfl_xor(ss, 8);
                const float rs = rsqrtf(ss * (1.0f / 128.0f) + EPS);
                u32x4 o; o.x = cvt_pk_bf16(v[0] * rs * g0[0], v[1] * rs * g0[1]); o.y = cvt_pk_bf16(v[2] * rs * g0[2], v[3] * rs * g0[3]);
                o.z = cvt_pk_bf16(v[4] * rs * g1[0], v[5] * rs * g1[1]); o.w = cvt_pk_bf16(v[6] * rs * g1[2], v[7] * rs * g1[3]);
                *(LAS u32x4*)(lds + q * 288 + ch * 16) = o; } }
            __syncthreads();
            if (s + pt.nb < nun) SGU_LOAD(s + pt.nb);
            f32x4 acc[1][8];
#pragma unroll
            for (int n = 0; n < 8; ++n) acc[0][n] = (f32x4){0.f, 0.f, 0.f, 0.f};
            mix_mma<1, 4>(acc, wf, lds, 288, 0, lane);
            const int p = 16 * w + fr; const float bias = P.b_spatial[h * 128 + p]; const size_t row = (size_t)chunk * 128 + p;
            const bf16_t* up = UB + row * 512 + 128 * h + 4 * g4; bf16_t* op = CAT + row * DM + 512 + 128 * h + 4 * g4;
#pragma unroll
            for (int n = 0; n < 8; ++n) { const u32x2 uu = *(const u32x2*)(up + 16 * n); const f32x4 sv = acc[0][n]; u32x2 o;
                o.x = cvt_pk_bf16(bf_lo(uu.x) * (sv[0] + bias), bf_hi(uu.x) * (sv[1] + bias)); o.y = cvt_pk_bf16(bf_lo(uu.y) * (sv[2] + bias), bf_hi(uu.y) * (sv[3] + bias));
                *(u32x2*)(op + 16 * n) = o; }
            __syncthreads();
        }
#undef SGU_LOAD
    }
}

__device__ void p3_dft2(const Params& P, LAS unsigned char* lds, int G) {
    const int tid = threadIdx.x, lane = tid & 63, w = __builtin_amdgcn_readfirstlane(tid >> 6), fr = lane & 15, g4 = lane >> 4;
    unsigned char* ws = P.ws;
    const bf16_t* TB = (const bf16_t*)P.out + (size_t)MTOK * DM; bf16_t* CAT = (bf16_t*)(ws + WS_CAT); const bf16_t* WB = (const bf16_t*)(ws + WS_WB);
    const int mrow[1] = {16 * w};
    bf16x8 wf[8][1]; mix_load_w<1, 8>(wf, WB, 256, mrow, lane);
    u32x4 xr[8];
#define P3_LOAD(uu) do { const int chunk_ = (uu) >> 2, grp_ = (uu) & 3; _Pragma("unroll") for (int i = 0; i < 8; ++i) { const int idx = tid + NTHR * i, ch = idx & 15, kp = idx >> 4, kin = kp >> 7, b = kp & 127; \
        xr[i] = *(const u32x4*)(TB + (size_t)(chunk_ * 128 + b) * DM + 256 * grp_ + 128 * kin + ch * 8); } } while (0)
    if ((int)blockIdx.x < 2560) P3_LOAD((int)blockIdx.x);
    for (int u = blockIdx.x; u < 2560; u += G) {
        const int chunk = u >> 2, grp = u & 3;
#pragma unroll
        for (int i = 0; i < 8; ++i) { const int idx = tid + NTHR * i, ch = idx & 15, kp = idx >> 4; *(LAS u32x4*)(lds + kp * 288 + ch * 16) = xr[i]; }
        __syncthreads();
        if (u + G < 2560) P3_LOAD(u + G);
        f32x4 acc[1][8];
#pragma unroll
        for (int n = 0; n < 8; ++n) acc[0][n] = (f32x4){0.f, 0.f, 0.f, 0.f};
        mix_mma<1, 8>(acc, wf, lds, 288, 0, lane);
        int seq0, Na, ka;
        if (chunk < 128) { seq0 = 0; Na = 128; ka = chunk; } else { const int cs = chunk - 128; seq0 = 16384 + 8192 * (cs >> 6); Na = 64; ka = cs & 63; }
        const int kb = 16 * w + fr; const size_t row = (size_t)seq0 + ka + (size_t)Na * kb;
        bf16_t* op = CAT + row * DM + 128 * grp + 4 * g4;
#pragma unroll
        for (int n = 0; n < 8; ++n) { const f32x4 v = acc[0][n]; u32x2 o; o.x = cvt_pk_bf16(v[0], v[1]); o.y = cvt_pk_bf16(v[2], v[3]); *(u32x2*)(op + 16 * n) = o; }
        __syncthreads();
    }
#undef P3_LOAD
}

__device__ void p5_rows(const Params& P, int G, const Part pt) {
    const int tid = threadIdx.x, lane = tid & 63, wave = tid >> 6;
    unsigned char* ws = P.ws;
    const bf16_t* MB = (const bf16_t*)(ws + WS_M); const float* SSQ = (const float*)(ws + WS_SSQM); bf16_t* H2 = (bf16_t*)(ws + WS_H2);
    { const u32x4 z = {0u, 0u, 0u, 0u};
      if (pt.px == 0) for (long it = (long)pt.rank * NTHR + tid; it < 256L * 128; it += (long)pt.nb * NTHR) { const long r = it >> 7, c = it & 127; *(u32x4*)(H2 + (r - 256) * DM + c * 8) = z; }
      if (pt.px == pt.nx - 1) for (long it = (long)pt.rank * NTHR + tid; it < 256L * 128; it += (long)pt.nb * NTHR) { const long r = it >> 7, c = it & 127; *(u32x4*)(H2 + ((long)MTOK + r) * DM + c * 8) = z; } }
    f32x4 gm[4];
#pragma unroll
    for (int i = 0; i < 4; ++i) gm[i] = *(const f32x4*)(P.post_mix_norm + i * 256 + lane * 4);
    const bf16_t* H0 = (const bf16_t*)(ws + WS_H0); const float* IRS0 = (const float*)(ws + WS_SSQC);
    const int rfirst = pt.r0 + pt.rank * 8 + wave, rstep = pt.nb * 16;
    const int nstep = (rfirst < pt.r1) ? (pt.r1 - 1 - rfirst) / rstep + 1 : 0;
    for (int jj = nstep - 1; jj >= 0; --jj) { const int r = rfirst + jj * rstep;
        int rw[2]; rw[0] = r; rw[1] = (r + pt.nb * 8 < pt.r1) ? r + pt.nb * 8 : r;
        u32x2 hw[2][4], mw[2][4]; float ssq[2], irs0[2];
#pragma unroll
        for (int q = 0; q < 2; ++q) { const size_t ro = (size_t)rw[q];
#pragma unroll
            for (int i = 0; i < 4; ++i) { hw[q][i] = *(const u32x2*)(H0 + ro * DM + i * 256 + lane * 4); mw[q][i] = *(const u32x2*)(MB + ro * DM + i * 256 + lane * 4); }
            ssq[q] = sum16(SSQ + ro * 16); irs0[q] = IRS0[ro * 16]; }
#pragma unroll
        for (int q = 0; q < 2; ++q) { const size_t ro = (size_t)rw[q];
            const float rsm = rsqrtf(ssq[q] * (1.0f / 1024.0f) + EPS), ir = irs0[q];
            f32x4 v[4]; float s = 0.f;
#pragma unroll
            for (int i = 0; i < 4; ++i) {
                v[i][0] = bf_lo(hw[q][i].x) * ir + bf_lo(mw[q][i].x) * rsm * gm[i][0]; v[i][1] = bf_hi(hw[q][i].x) * ir + bf_hi(mw[q][i].x) * rsm * gm[i][1];
                v[i][2] = bf_lo(hw[q][i].y) * ir + bf_lo(mw[q][i].y) * rsm * gm[i][2]; v[i][3] = bf_hi(hw[q][i].y) * ir + bf_hi(mw[q][i].y) * rsm * gm[i][3];
                s += (v[i][0] * v[i][0] + v[i][1] * v[i][1]) + (v[i][2] * v[i][2] + v[i][3] * v[i][3]); }
#pragma unroll
            for (int o = 1; o < 64; o <<= 1) s += __shfl_xor(s, o);
            const float rs = rsqrtf(s * (1.0f / 1024.0f) + EPS);
            if (lane == 0) ((float*)SSQ)[ro * 16] = 1.0f / rs;
#pragma unroll
            for (int i = 0; i < 4; ++i) { u32x2 w; w.x = cvt_pk_bf16(v[i][0] * rs, v[i][1] * rs); w.y = cvt_pk_bf16(v[i][2] * rs, v[i][3] * rs);
                *(u32x2*)(H2 + ro * DM + i * 256 + lane * 4) = w; }
        }
    }
}
__device__ void p8_rows(const Params& P, int G, const Part pt) {
    const int tid = threadIdx.x, lane = tid & 63, wave = tid >> 6;
    unsigned char* ws = P.ws;
    const bf16_t* CB = (const bf16_t*)(ws + WS_C); const float* SSQ = (const float*)(ws + WS_SSQC); const bf16_t* H2 = (const bf16_t*)(ws + WS_H2); const float* IRS = (const float*)(ws + WS_SSQM);
    f32x4 gm[4];
#pragma unroll
    for (int i = 0; i < 4; ++i) gm[i] = *(const f32x4*)(P.post_ffn_norm + i * 256 + lane * 4);
    for (int r = pt.r0 + pt.rank * 8 + wave; r < pt.r1; r += pt.nb * 8) {
        const f32x4 s0 = *(const f32x4*)(SSQ + (size_t)r * 16), s1 = *(const f32x4*)(SSQ + (size_t)r * 16 + 4), s2 = *(const f32x4*)(SSQ + (size_t)r * 16 + 8), s3 = *(const f32x4*)(SSQ + (size_t)r * 16 + 12);
        const float ssq = ((s0[0] + s0[1]) + (s0[2] + s0[3])) + ((s1[0] + s1[1]) + (s1[2] + s1[3])) + ((s2[0] + s2[1]) + (s2[2] + s2[3])) + ((s3[0] + s3[1]) + (s3[2] + s3[3]));
        const float rsm = rsqrtf(ssq * (1.0f / 1024.0f) + EPS); const float irs = IRS[(size_t)r * 16];
#pragma unroll
        for (int i = 0; i < 4; ++i) { const u32x2 hw = *(const u32x2*)(H2 + (size_t)r * DM + i * 256 + lane * 4); const u32x2 cw = *(const u32x2*)(CB + (size_t)r * DM + i * 256 + lane * 4);
            f32x4 xv;
            xv[0] = bf_lo(hw.x) * irs + bf_lo(cw.x) * rsm * gm[i][0]; xv[1] = bf_hi(hw.x) * irs + bf_hi(cw.x) * rsm * gm[i][1];
            xv[2] = bf_lo(hw.y) * irs + bf_lo(cw.y) * rsm * gm[i][2]; xv[3] = bf_hi(hw.y) * irs + bf_hi(cw.y) * rsm * gm[i][3];
            *(f32x4*)(P.out + (size_t)r * DM + i * 256 + lane * 4) = xv; }
    }
}


#ifdef DIAG_CHK
__device__ const int chk_rows[24] = {0, 1, 61, 62, 63, 127, 128, 247, 248, 255, 256, 8191, 8192, 16383, 16384, 16385, 24575, 24576, 40000, 65535, 65536, 81791, 81918, 81919};
constexpr int NCHK = 24;
__device__ __forceinline__ float bf2f(bf16_t b) { return __uint_as_float(((unsigned)b) << 16); }
__device__ __forceinline__ float gelu_ref(float x) { return 0.5f * x * (1.0f + tanhf(0.7978845608f * (x + 0.044715f * x * x * x))); }
__device__ __forceinline__ bool bad(float got, float ref, float rel, float ab) { return !(fabsf(got - ref) <= rel * fabsf(ref) + ab); }
__device__ float block_sum(float v, LAS float* red) {
    for (int o = 1; o < 64; o <<= 1) v += __shfl_xor(v, o);
    __syncthreads();
    if ((threadIdx.x & 63) == 0) red[threadIdx.x >> 6] = v;
    __syncthreads();
    float t = 0.f; for (int i = 0; i < NTHR / 64; ++i) t += red[i];
    __syncthreads();
    return t;
}
__device__ void chk_p1(const Params& P, LAS unsigned char* lds, unsigned* flags) {
    if (blockIdx.x >= NCHK) return;
    const int r = chk_rows[blockIdx.x], tid = threadIdx.x; unsigned char* ws = P.ws;
    LAS float* red = (LAS float*)lds; LAS float* hn = red + 16; LAS float* z = hn + 1024;
    const float* xp = xrow(P, r);
    float s = 0.f; for (int k = tid; k < 1024; k += NTHR) s += xp[k] * xp[k];
    s = block_sum(s, red); const float rs = rsqrtf(s / 1024.0f + EPS);
    for (int k = tid; k < 1024; k += NTHR) hn[k] = xp[k] * rs * P.pre_mix_norm[k];
    __syncthreads();
    for (int c = tid; c < 1536; c += NTHR) { float a = 0.f; for (int k = 0; k < 1024; ++k) a += hn[k] * P.w_in[(size_t)k * 1536 + c]; z[c] = a; }
    __syncthreads();
    const bf16_t* YB = (const bf16_t*)(ws + WS_Y); const bf16_t* UB = (const bf16_t*)(ws + WS_U); const bf16_t* VB = (const bf16_t*)(ws + WS_V);
    bool b1 = false, b2 = false;
    for (int n = tid; n < 1024; n += NTHR) { const int grp = n >> 8, im = (n >> 7) & 1, l = n & 127; float a = 0.f;
        for (int c = 0; c < 128; ++c) a += z[128 * grp + c] * cospif((float)((l * c + 32 * im) & 127) / 64.0f);
        a *= 0.08838834764831845f; if (bad(bf2f(YB[(size_t)r * 1024 + n]), a, 0.03f, 0.03f)) b1 = true; }
    for (int j = tid; j < 512; j += NTHR) { if (bad(bf2f(UB[(size_t)r * 512 + j]), gelu_ref(z[512 + j]), 0.03f, 0.03f)) b2 = true; if (bad(bf2f(VB[(size_t)r * 512 + j]), gelu_ref(z[1024 + j]), 0.03f, 0.03f)) b2 = true; }
    if (b1) flags[1] = 1u; if (b2) flags[2] = 1u;
}
__device__ void chk_p3(const Params& P, LAS unsigned char* lds, unsigned* flags) {
    if (blockIdx.x >= NCHK) return;
    const int r = chk_rows[blockIdx.x], tid = threadIdx.x; unsigned char* ws = P.ws;
    const bf16_t* YB = (const bf16_t*)(ws + WS_Y); const bf16_t* UB = (const bf16_t*)(ws + WS_U); const bf16_t* VB = (const bf16_t*)(ws + WS_V); const bf16_t* CAT = (const bf16_t*)(ws + WS_CAT);
    { const int seq0 = r < 16384 ? 0 : 16384 + ((r - 16384) >> 13) * 8192, S = r < 16384 ? 16384 : 8192, k = r - seq0; const int grp = tid >> 7, l = tid & 127;
      float a = 0.f;
      for (int sidx = 0; sidx < S; ++sidx) { const unsigned ph = ((unsigned)k * (unsigned)sidx) & (unsigned)(S - 1); float sn, cs; sincospif(2.0f * (float)ph / (float)S, &sn, &cs);
          const bf16_t* yp = YB + (size_t)(seq0 + sidx) * 1024 + 256 * grp + l; a += bf2f(yp[0]) * cs + bf2f(yp[128]) * sn; }
      a *= rsqrtf((float)S);
      if (bad(bf2f(CAT[(size_t)r * 1024 + 128 * grp + l]), a, 0.03f, 0.03f)) flags[3] = 1u; }
    { LAS float* rsq = (LAS float*)lds; const int chunk = r >> 7, p = r & 127;
      { const int q = tid >> 2, h = tid & 3; float ss = 0.f; for (int c = 0; c < 128; ++c) { const float v = bf2f(VB[(size_t)(chunk * 128 + q) * 512 + 128 * h + c]); ss += v * v; } rsq[q * 4 + h] = rsqrtf(ss / 128.0f + EPS); }
      __syncthreads();
      const int h = tid >> 7, c = tid & 127; float sv = 0.f;
      for (int q = 0; q < 128; ++q) sv += P.w_spatial[(h * 128 + p) * 128 + q] * bf2f(VB[(size_t)(chunk * 128 + q) * 512 + 128 * h + c]) * rsq[q * 4 + h] * P.sgu_norm[h * 128 + c];
      const float gval = bf2f(UB[(size_t)r * 512 + 128 * h + c]) * (sv + P.b_spatial[h * 128 + p]);
      if (bad(bf2f(CAT[(size_t)r * 1024 + 512 + 128 * h + c]), gval, 0.03f, 0.03f)) flags[4] = 1u;
      __syncthreads(); }
}
__device__ void chk_p4(const Params& P, LAS unsigned char* lds, unsigned* flags) {
    if (blockIdx.x >= NCHK) return;
    const int r = chk_rows[blockIdx.x], tid = threadIdx.x; unsigned char* ws = P.ws;
    const bf16_t* CAT = (const bf16_t*)(ws + WS_CAT); const bf16_t* MB = (const bf16_t*)(ws + WS_M); const float* SSQ = (const float*)(ws + WS_SSQM);
    LAS float* red = (LAS float*)lds; float sq = 0.f;
    for (int n = tid; n < 1024; n += NTHR) { float a = 0.f; for (int k = 0; k < 1024; ++k) a += bf2f(CAT[(size_t)r * 1024 + k]) * P.w_out[(size_t)k * 1024 + n];
        if (bad(bf2f(MB[(size_t)r * 1024 + n]), a, 0.03f, 0.03f)) flags[5] = 1u; sq += a * a; }
    sq = block_sum(sq, red); float s2 = 0.f; for (int i = 0; i < 16; ++i) s2 += SSQ[(size_t)r * 16 + i];
    if (bad(s2, sq, 0.03f, 0.01f)) flags[6] = 1u;
}
__device__ void chk_p5(const Params& P, LAS unsigned char* lds, unsigned* flags) {
    if (blockIdx.x >= NCHK) return;
    const int r = chk_rows[blockIdx.x], tid = threadIdx.x; unsigned char* ws = P.ws;
    const bf16_t* MB = (const bf16_t*)(ws + WS_M); const bf16_t* H2 = (const bf16_t*)(ws + WS_H2);
    LAS float* red = (LAS float*)lds; const float* xp = xrow(P, r);
    float sq = 0.f; for (int n = tid; n < 1024; n += NTHR) { const float m = bf2f(MB[(size_t)r * 1024 + n]); sq += m * m; }
    sq = block_sum(sq, red); const float rsm = rsqrtf(sq / 1024.0f + EPS);
    float x1[2]; float s1 = 0.f;
    for (int i = 0; i < 2; ++i) { const int n = tid + i * NTHR; x1[i] = xp[n] + bf2f(MB[(size_t)r * 1024 + n]) * rsm * P.post_mix_norm[n]; s1 += x1[i] * x1[i];
        if (bad(P.out[(size_t)r * 1024 + n], x1[i], 0.02f, 0.02f)) flags[7] = 1u; }
    s1 = block_sum(s1, red); const float rs2 = rsqrtf(s1 / 1024.0f + EPS);
    for (int i = 0; i < 2; ++i) { const int n = tid + i * NTHR; if (bad(bf2f(H2[(size_t)r * 1024 + n]), x1[i] * rs2, 0.03f, 0.03f)) flags[8] = 1u; }
}
__device__ void chk_p6(const Params& P, LAS unsigned char* lds, unsigned* flags) {
    if (blockIdx.x >= NCHK) return;
    const int r = chk_rows[blockIdx.x], tid = threadIdx.x; unsigned char* ws = P.ws;
    const bf16_t* H2 = (const bf16_t*)(ws + WS_H2); const bf16_t* HID = (const bf16_t*)(ws + WS_HID);
    LAS float* hh = (LAS float*)lds;
    const bool first = (r == 0) || (r >= 16384 && (r & 8191) == 0), last = ((r + 1) >= 16384 && ((r + 1) & 8191) == 0);
    for (int i = tid; i < 3072; i += NTHR) { const int d = i >> 10, k = i & 1023; const bool ok = (d == 1) || (d == 0 && !first) || (d == 2 && !last);
        hh[i] = ok ? bf2f(H2[(size_t)(r + d - 1) * 1024 + k]) * P.pre_ffn_norm[k] : 0.f; }
    __syncthreads();
    for (int j = tid; j < DFF; j += NTHR) { float g[3] = {0.f, 0.f, 0.f}, u[3] = {0.f, 0.f, 0.f};
        for (int k = 0; k < 1024; ++k) { const float wg = P.w_up[(size_t)k * N3 + j], wu = P.w_up[(size_t)k * N3 + DFF + j];
            g[0] += hh[k] * wg; g[1] += hh[1024 + k] * wg; g[2] += hh[2048 + k] * wg; u[0] += hh[k] * wu; u[1] += hh[1024 + k] * wu; u[2] += hh[2048 + k] * wu; }
        const float gv = g[0] * P.conv_w[j] + g[1] * P.conv_w[N3 + j] + g[2] * P.conv_w[2 * N3 + j] + P.conv_b[j];
        const float uv = u[0] * P.conv_w[DFF + j] + u[1] * P.conv_w[N3 + DFF + j] + u[2] * P.conv_w[2 * N3 + DFF + j] + P.conv_b[DFF + j];
        if (bad(bf2f(HID[(size_t)r * DFF + j]), gelu_ref(gv) * uv, 0.04f, 0.04f)) flags[9] = 1u; }
    __syncthreads();
}
__device__ void chk_p7(const Params& P, LAS unsigned char* lds, unsigned* flags) {
    if (blockIdx.x >= NCHK) return;
    const int r = chk_rows[blockIdx.x], tid = threadIdx.x; unsigned char* ws = P.ws;
    const bf16_t* HID = (const bf16_t*)(ws + WS_HID); const bf16_t* CB = (const bf16_t*)(ws + WS_C);
    for (int n = tid; n < 1024; n += NTHR) { float a = 0.f; for (int k = 0; k < DFF; ++k) a += bf2f(HID[(size_t)r * DFF + k]) * P.w_down[(size_t)k * 1024 + n];
        if (bad(bf2f(CB[(size_t)r * 1024 + n]), a, 0.03f, 0.03f)) flags[10] = 1u; }
}
#endif
__device__ __forceinline__ void grid_barrier(unsigned* cnt, unsigned target) {
    asm volatile("s_waitcnt vmcnt(0) lgkmcnt(0)" ::: "memory");
    __syncthreads();
    if (threadIdx.x == 0) {
        __builtin_amdgcn_fence(__ATOMIC_RELEASE, "agent");
        asm volatile("s_waitcnt vmcnt(0)" ::: "memory");
        __hip_atomic_fetch_add(cnt, 1u, __ATOMIC_RELAXED, __HIP_MEMORY_SCOPE_AGENT);
        while (__hip_atomic_load(cnt, __ATOMIC_RELAXED, __HIP_MEMORY_SCOPE_AGENT) < target) __builtin_amdgcn_s_sleep(1);
        __builtin_amdgcn_fence(__ATOMIC_ACQUIRE, "agent");
        asm volatile("s_waitcnt vmcnt(0)" ::: "memory");
    }
    __syncthreads();
}
__device__ __forceinline__ void nbr_barrier(unsigned* base, int px, int nx, unsigned target) {
    asm volatile("s_waitcnt vmcnt(0) lgkmcnt(0)" ::: "memory");
    __syncthreads();
    if (threadIdx.x == 0) {
        __builtin_amdgcn_fence(__ATOMIC_RELEASE, "agent");
        asm volatile("s_waitcnt vmcnt(0)" ::: "memory");
        __hip_atomic_fetch_add(base + 64 * px, 1u, __ATOMIC_RELAXED, __HIP_MEMORY_SCOPE_AGENT);
        while (__hip_atomic_load(base + 64 * px, __ATOMIC_RELAXED, __HIP_MEMORY_SCOPE_AGENT) < target) __builtin_amdgcn_s_sleep(1);
        if (px > 0) while (__hip_atomic_load(base + 64 * (px - 1), __ATOMIC_RELAXED, __HIP_MEMORY_SCOPE_AGENT) < target) __builtin_amdgcn_s_sleep(1);
        if (px + 1 < nx) while (__hip_atomic_load(base + 64 * (px + 1), __ATOMIC_RELAXED, __HIP_MEMORY_SCOPE_AGENT) < target) __builtin_amdgcn_s_sleep(1);
        __builtin_amdgcn_fence(__ATOMIC_ACQUIRE, "agent");
        asm volatile("s_waitcnt vmcnt(0)" ::: "memory");
    }
    __syncthreads();
}
__device__ __forceinline__ void grid_barrier2(unsigned* base, int px, int nx, unsigned nb, unsigned phase) {
    asm volatile("s_waitcnt vmcnt(0) lgkmcnt(0)" ::: "memory");
    __syncthreads();
    if (threadIdx.x == 0) {
        __builtin_amdgcn_fence(__ATOMIC_RELEASE, "agent");
        asm volatile("s_waitcnt vmcnt(0)" ::: "memory");
        unsigned* xa = base + 2560 + 64 * px; unsigned* top = base + 3072; unsigned* gen = base + 3136;
        const unsigned old = __hip_atomic_fetch_add(xa, 1u, __ATOMIC_RELAXED, __HIP_MEMORY_SCOPE_AGENT);
        if (old == nb * phase - 1u) {
            const unsigned t = __hip_atomic_fetch_add(top, 1u, __ATOMIC_RELAXED, __HIP_MEMORY_SCOPE_AGENT);
            if (t == (unsigned)nx * phase - 1u) for (int q = 0; q < nx; ++q) __hip_atomic_store(gen + 64 * q, phase, __ATOMIC_RELAXED, __HIP_MEMORY_SCOPE_AGENT);
        }
        while (__hip_atomic_load(gen + 64 * px, __ATOMIC_RELAXED, __HIP_MEMORY_SCOPE_AGENT) < phase) __builtin_amdgcn_s_sleep(1);
        __builtin_amdgcn_fence(__ATOMIC_ACQUIRE, "agent");
        asm volatile("s_waitcnt vmcnt(0)" ::: "memory");
    }
    __syncthreads();
}
#define GRID_SYNC1() do { ++bar1_phase; grid_barrier(bar_cnt, (unsigned)G * bar1_phase); } while (0)
#define GRID_SYNC() do { ++bar_phase; grid_barrier2(bar_cnt, pt.px, pt.nx, (unsigned)pt.nb, bar_phase); } while (0)
__device__ void cksum(const unsigned char* p, size_t nbytes, unsigned long long* slot, int G) {
    unsigned long long s = 0;
    for (size_t i = (size_t)blockIdx.x * NTHR + threadIdx.x; i < nbytes / 16; i += (size_t)G * NTHR) { const u32x4 v = *(const u32x4*)(p + i * 16); s += (unsigned long long)v.x + v.y + v.z + v.w; }
    for (int o = 1; o < 64; o <<= 1) { const unsigned lo = __shfl_xor((unsigned)s, o), hi = __shfl_xor((unsigned)(s >> 32), o); s += ((unsigned long long)hi << 32) | lo; }
    if ((threadIdx.x & 63) == 0) __hip_atomic_fetch_add(slot, s, __ATOMIC_RELAXED, __HIP_MEMORY_SCOPE_AGENT);
}
__global__ void __launch_bounds__(NTHR, 2) fwd_megakernel(Params P) {
    extern __shared__ __attribute__((aligned(16))) unsigned char lds_raw[];
    LAS unsigned char* lds = (LAS unsigned char*)lds_raw;
    cg::grid_group grid = cg::this_grid();
    const int G = gridDim.x;
    unsigned char* ws = P.ws;
    unsigned* bar_cnt = (unsigned*)(ws + WS_BAR); unsigned bar_phase = 0, pbar_phase = 0, bar1_phase = 0; (void)bar1_phase;
    if (P.never) grid.sync();

    const int lo = P.ph_lo, hi = P.ph_hi;
#define IN(k) (lo <= (k) && (k) < hi)
#define SEAM(k) do { if (IN(k) && IN((k) + 1)) GRID_SYNC(); } while (0)
#define NSEAM(k) do { if (IN(k) && IN((k) + 1)) { ++pbar_phase; nbr_barrier(bar_cnt + 2048, pt.px, pt.nx, (unsigned)pt.nb * pbar_phase); } } while (0)
#define PSEAM(k) do { if (IN(k) && IN((k) + 1)) { ++pbar_phase; grid_barrier(bar_cnt + 2048 + 64 * pt.px, (unsigned)pt.nb * pbar_phase); } } while (0)
    Part pt;
    if (P.census) {
        unsigned* xc = (unsigned*)(ws + WS_BAR + 1024);
        LAS unsigned* lw = (LAS unsigned*)lds;
        if (threadIdx.x == 0) {
            const unsigned xcc = (unsigned)__builtin_amdgcn_s_getreg((3 << 11) | 20) & 0xFu;
            lw[0] = xcc; lw[1] = __hip_atomic_fetch_add(xc + 16 * xcc, 1u, __ATOMIC_RELAXED, __HIP_MEMORY_SCOPE_AGENT);
        }
        GRID_SYNC1();
        const unsigned xcc = lw[0], rank = lw[1];
        int nx = 0, px = 0, nb = 1;
        for (unsigned jx = 0; jx < 16; ++jx) { const unsigned c = __hip_atomic_load(xc + 16 * jx, __ATOMIC_RELAXED, __HIP_MEMORY_SCOPE_AGENT); if (c) { if (jx < xcc) ++px; ++nx; } if (jx == xcc) nb = (int)c; }
        const int t0 = (320 * px) / nx, t1 = (320 * (px + 1)) / nx;
        pt.r0 = __builtin_amdgcn_readfirstlane(t0 * 256); pt.r1 = __builtin_amdgcn_readfirstlane(t1 * 256);
        pt.nb = __builtin_amdgcn_readfirstlane(nb); pt.rank = __builtin_amdgcn_readfirstlane((int)rank); pt.px = __builtin_amdgcn_readfirstlane(px); pt.nx = __builtin_amdgcn_readfirstlane(nx);
        __syncthreads();
    } else {
        const int nx = (G % 8 == 0) ? 8 : 1, px = (int)blockIdx.x % nx;
        pt.r0 = ((320 * px) / nx) * 256; pt.r1 = ((320 * (px + 1)) / nx) * 256; pt.nb = G / nx; pt.rank = (int)blockIdx.x / nx; pt.px = px; pt.nx = nx;
    }
    const int nMp = (pt.r1 - pt.r0) >> 8;

    if (IN(0)) p0_prep(P, lds, G, pt);
    SEAM(0);
    if (IN(1)) {
        pg8::Gemm g{(const bf16_t*)(ws + WS_H0), (const bf16_t*)(ws + WS_W1T), DM};
        pg8::PartOrder S{pt.r0, 256, nMp, N1 / 256, pt.nb, pt.rank};
        EpiZ E{(bf16_t*)P.out, (bf16_t*)(ws + WS_U), (bf16_t*)(ws + WS_V)};
        pg8::gemm_phase<EpiZ, false>(lds, g, S, E);
    }
    SEAM(1);
    if (IN(2)) p2_mix(P, lds, G, pt);
    SEAM(2);
    if (IN(3)) p3_dft2(P, lds, G);
    SEAM(3);
    if (IN(4)) {
        pg8::Gemm g{(const bf16_t*)(ws + WS_CAT), (const bf16_t*)(ws + WS_W2T), DM};
        pg8::PartOrder S{pt.r0, 256, nMp, DM / 256, pt.nb, pt.rank};
        EpiMS E{(bf16_t*)(ws + WS_M), (float*)(ws + WS_SSQM)};
        pg8::gemm_phase<EpiMS, false>(lds, g, S, E);
    }
    PSEAM(4);
    if (IN(5)) p5_rows(P, G, pt);
    NSEAM(5);
    if (IN(6)) {
        pg8::Gemm g{(const bf16_t*)(ws + WS_H2), (const bf16_t*)(ws + WS_W3T), DM};
        pg8::PartOrder S{pt.r0, 248, (pt.r1 - pt.r0 + 247) / 248, N3 / 256, pt.nb, pt.rank};
        EpiFFN E{(bf16_t*)(ws + WS_HID), P.conv_w, P.conv_b, pt.r1};
        pg8::gemm_phase<EpiFFN, true>(lds, g, S, E);
    }
    PSEAM(6);
    const bool fuse_ok = (pt.nb % 32 == 0) && (nMp % 8 == 0) && (lo == 0) && (hi == 9);
    if (IN(7)) {
        pg8::Gemm g{(const bf16_t*)(ws + WS_HID), (const bf16_t*)(ws + WS_W4T), DFF};
        pg8::PartOrder S{pt.r0, 256, nMp, DM / 256, pt.nb, pt.rank};
        if (fuse_ok) {
            EpiY E{P.out, (const bf16_t*)(ws + WS_H2), (const float*)(ws + WS_SSQM), (float*)(ws + WS_SSQC), (unsigned*)(ws + WS_BAR + 4096), P.post_ffn_norm};
            pg8::gemm_phase<EpiY, false>(lds, g, S, E);
        } else {
            EpiMS E{(bf16_t*)(ws + WS_C), (float*)(ws + WS_SSQC)};
            pg8::gemm_phase<EpiMS, false>(lds, g, S, E);
        }
    }
    if (!fuse_ok) SEAM(7);
#ifdef DIAG_DET
    if (P.ck >= 0) {
        unsigned long long* slots = (unsigned long long*)(ws + WS_BAR + 4096);
        GRID_SYNC();
        const unsigned char* p1 = ws; size_t n1 = 0; const unsigned char* p2 = ws; size_t n2 = 0;
        switch (lo) {
            case 0: p1 = ws; n1 = WS_BAR; p2 = ws + WS_H0; n2 = ACT; break;
            case 1: p1 = (const unsigned char*)P.out; n1 = ACT; p2 = ws + WS_U; n2 = ACT; break;
            case 2: p1 = (const unsigned char*)P.out + ACT; n1 = ACT; break;
            case 3: p1 = ws + WS_CAT; n1 = ACT; break;
            case 4: p1 = ws + WS_M; n1 = ACT; p2 = ws + WS_SSQM; n2 = 5 * MiB; break;
            case 5: p1 = ws + WS_H2R; n1 = 161 * MiB; p2 = (const unsigned char*)P.out; n2 = 2 * ACT; break;
            case 6: p1 = ws + WS_HID; n1 = 440 * MiB; break;
            case 7: p1 = ws + WS_C; n1 = ACT; p2 = ws + WS_SSQC; n2 = 5 * MiB; break;
            default: break;
        }
        cksum(p1, n1, slots + 2 * lo + P.ck, G); cksum(p2, n2, slots + 32 + 2 * lo + P.ck, G);
    }
    if (IN(8)) {
        const unsigned long long* slots = (const unsigned long long*)(ws + WS_BAR + 4096); int code = 0;
        for (int k = 7; k >= 0; --k) { if (slots[32 + 2 * k] != slots[32 + 2 * k + 1]) code = 2 * k + 2; if (slots[2 * k] != slots[2 * k + 1]) code = 2 * k + 1; }
        if (code) { const float al = (float)(code + 2);
            for (size_t i = (size_t)blockIdx.x * NTHR + threadIdx.x; i < (size_t)MTOK * DM; i += (size_t)G * NTHR) { const int r = (int)(i >> 10), c = (int)(i & 1023); P.out[i] = al * xrow(P, r)[c]; }
            return; }
    }
#endif
    if (IN(8) && !fuse_ok) p8_rows(P, G, pt);
#undef IN
#undef SEAM
}

extern "C" void kernel_launch(void* const* d_in, const int* in_sizes, int n_in, void* d_out, int out_size, void* d_ws, size_t ws_size, hipStream_t stream) {
    static int grid_blocks = 0;
    if (grid_blocks == 0) {
        if (n_in != 15 || ws_size < WS_END) { fprintf(stderr, "kernel_launch: unexpected n_in %d or ws_size %zu (< %zu)\n", n_in, ws_size, (size_t)WS_END); grid_blocks = -1; return; }
        int dev = 0, cus = 0, per_cu = 0;
        (void)hipGetDevice(&dev);
        (void)hipDeviceGetAttribute(&cus, hipDeviceAttributeMultiprocessorCount, dev);
        if (hipFuncSetAttribute((const void*)fwd_megakernel, hipFuncAttributeMaxDynamicSharedMemorySize, LDS_BYTES) != hipSuccess) { fprintf(stderr, "kernel_launch: hipFuncSetAttribute failed\n"); grid_blocks = -1; return; }
        if (hipOccupancyMaxActiveBlocksPerMultiprocessor(&per_cu, (const void*)fwd_megakernel, NTHR, LDS_BYTES) != hipSuccess || per_cu < 1) { fprintf(stderr, "kernel_launch: occupancy query gave %d\n", per_cu); grid_blocks = -1; return; }
        grid_blocks = cus * per_cu;
    }
    if (grid_blocks < 0) return;
    Params p{};
    p.x_prompt = (const float*)d_in[0]; p.x_sample = (const float*)d_in[1]; p.pre_mix_norm = (const float*)d_in[2]; p.w_in = (const float*)d_in[3]; p.sgu_norm = (const float*)d_in[4];
    p.w_spatial = (const float*)d_in[5]; p.b_spatial = (const float*)d_in[6]; p.w_out = (const float*)d_in[7]; p.post_mix_norm = (const float*)d_in[8]; p.pre_ffn_norm = (const float*)d_in[9];
    p.w_up = (const float*)d_in[10]; p.conv_w = (const float*)d_in[11]; p.conv_b = (const float*)d_in[12]; p.w_down = (const float*)d_in[13]; p.post_ffn_norm = (const float*)d_in[14];
    p.out = (float*)d_out; p.ws = (unsigned char*)d_ws;
    p.never = 0;
    hipError_t e = hipSuccess;
#if N_LAUNCHES == 1
    p.census = 0; p.ph_lo = 0; p.ph_hi = 9; p.ck = -1;
    (void)hipMemsetAsync((char*)d_ws + WS_BAR, 0, 16384, stream);
    { void* args[] = {&p}; e = hipLaunchCooperativeKernel((const void*)fwd_megakernel, dim3(grid_blocks), dim3(NTHR), args, LDS_BYTES, stream); }
#else
    (void)hipMemsetAsync((char*)d_ws + WS_BAR, 0, 16384, stream);
    for (int k = 0; k < 9 && e == hipSuccess; ++k) {
#ifdef DIAG_DET
        for (int rep = 0; rep < (k < 8 ? 2 : 1); ++rep) {
            (void)hipMemsetAsync((char*)d_ws + WS_BAR, 0, 1024, stream);
            p.census = 0; p.ph_lo = k; p.ph_hi = k + 1; p.ck = (k < 8) ? rep : -1;
            void* args[] = {&p}; e = hipLaunchCooperativeKernel((const void*)fwd_megakernel, dim3(grid_blocks), dim3(NTHR), args, LDS_BYTES, stream);
        }
#else
        p.census = 0; p.ph_lo = k; p.ph_hi = k + 1; p.ck = -1;
        void* args[] = {&p}; e = hipLaunchCooperativeKernel((const void*)fwd_megakernel, dim3(grid_blocks), dim3(NTHR), args, LDS_BYTES, stream);
#endif
    }
#endif
    if (e != hipSuccess) fprintf(stderr, "cooperative launch failed: %s (grid %d)\n", hipGetErrorString(e), grid_blocks);
}
```
